# Optimizing an MI355X kernel written in HIP

```python
import jax, jax.numpy as jnp
from jax import lax
import numpy as np

D_MODEL = 2048
BATCH = 1
SEQ = 8192
DEPTH = 2
DEC_BATCH = 128
DEC_SEQ = 4
PAST_LEN = 8192
PAGE_SIZE = 128

MIX_W = D_MODEL // 2
N_BRANCH = 4
A_DK = 128
A_HEADS = MIX_W // A_DK
A_DV = MIX_W // A_HEADS
HGRN_CHUNK = 32
POOL_WINDOWS = (2, 4, 8, 16)
POOL_GROUPS = len(POOL_WINDOWS)
POOL_GC = MIX_W // POOL_GROUPS
POOL_BUF = max(POOL_WINDOWS) - 1
SWA_HEAD_DIM = 64
SWA_Q_HEADS = MIX_W // SWA_HEAD_DIM
SWA_KV_HEADS = SWA_Q_HEADS // 4
SWA_GROUP = SWA_Q_HEADS // SWA_KV_HEADS
WINDOW = 128
ROT_DIM = SWA_HEAD_DIM // 4
ROPE_THETA = 500000.0
N_MEM = 256
MEM_HEADS = 4
MEM_HEAD_DIM = MIX_W // MEM_HEADS
D_FF = 11 * D_MODEL // 4
CONV_W = 3
EPS = 1e-6
IN_SPLIT_SIZES = (MIX_W, MIX_W, MIX_W, MIX_W, MIX_W, MIX_W,
                  SWA_KV_HEADS * SWA_HEAD_DIM, SWA_KV_HEADS * SWA_HEAD_DIM, MIX_W, N_BRANCH * D_MODEL)
IN_COLS = sum(IN_SPLIT_SIZES)

kernel_name = "hybrid_hgrn2_pool_swa_mem_decoder_step"


def rms_norm(x, g):
    xf = x.astype(jnp.float32)
    y = xf * lax.rsqrt(jnp.mean(xf * xf, axis=-1, keepdims=True) + EPS)
    return (y * g.astype(jnp.float32)).astype(x.dtype)


def split_cols(p):
    idx = []
    acc = 0
    for sz in IN_SPLIT_SIZES[:-1]:
        acc += sz
        idx.append(acc)
    return jnp.split(p, idx, axis=-1)


def partial_rope(x, pos):
    half = ROT_DIM // 2
    inv = jnp.power(ROPE_THETA, -jnp.arange(0, ROT_DIM, 2, dtype=jnp.float32) / ROT_DIM)
    ang = pos.astype(jnp.float32)[:, None] * inv[None, :]
    cos = jnp.cos(ang)[None, :, None, :]
    sin = jnp.sin(ang)[None, :, None, :]
    xr = x[..., :ROT_DIM].astype(jnp.float32)
    x1, x2 = xr[..., :half], xr[..., half:]
    rot = jnp.concatenate([x1 * cos - x2 * sin, x2 * cos + x1 * sin], axis=-1)
    return jnp.concatenate([rot.astype(x.dtype), x[..., ROT_DIM:]], axis=-1)


def hgrn2_chunked(q, k, v, log_f, s0):
    B, L, H, DK = q.shape
    DV = v.shape[-1]
    C = min(HGRN_CHUNK, L)
    pad = (-L) % C
    q, k, v, log_f = (t.astype(jnp.float32) for t in (q, k, v, log_f))
    if pad:
        cfg = ((0, 0), (0, pad), (0, 0), (0, 0))
        q, k, v, log_f = (jnp.pad(t, cfg) for t in (q, k, v, log_f))
    n = (L + pad) // C

    def to_chunks(t):
        return t.reshape(B, n, C, H, t.shape[-1]).transpose(1, 0, 3, 2, 4)

    causal = jnp.tril(jnp.ones((C, C), dtype=bool))[:, :, None]

    def step(S, inp):
        qc, kc, vc, gc = inp
        b = jnp.cumsum(gc, axis=2)
        o_inter = jnp.einsum('bhtd,bhde->bhte', qc * jnp.exp(b), S)
        decay = jnp.exp(jnp.where(causal, b[:, :, :, None, :] - b[:, :, None, :, :], -jnp.inf))
        att = jnp.einsum('bhtd,bhsd,bhtsd->bhts', qc, kc, decay)
        o = o_inter + jnp.einsum('bhts,bhse->bhte', att, vc)
        b_last = b[:, :, -1:, :]
        S = jnp.exp(b_last[:, :, 0, :, None]) * S + jnp.einsum('bhsd,bhse->bhde', kc * jnp.exp(b_last - b), vc)
        return S, o

    S, o = lax.scan(step, s0.astype(jnp.float32),
                    (to_chunks(q), to_chunks(k), to_chunks(v), to_chunks(log_f)))
    o = o.transpose(1, 0, 3, 2, 4).reshape(B, n * C, H, DV)[:, :L]
    return S, o


def pool_mixer(u, buf, pos, pool_w, pool_scale):
    B, L, _ = u.shape
    P = buf.shape[1]
    ext = jnp.concatenate([buf, u], axis=1).astype(jnp.float32)
    c = jnp.concatenate([jnp.zeros((B, 1, MIX_W), jnp.float32), jnp.cumsum(ext, axis=1)], axis=1)
    hi = c[:, P + 1:]
    uf = u.astype(jnp.float32)
    outs = []
    for g, win in enumerate(POOL_WINDOWS):
        sl = slice(g * POOL_GC, (g + 1) * POOL_GC)
        lo = c[:, P + 1 - win:P + 1 - win + L, sl]
        cnt = jnp.minimum(pos + 1, win).astype(jnp.float32)[None, :, None]
        outs.append((hi[..., sl] - lo) / cnt - uf[..., sl])
    d = jnp.stack(outs, axis=2)
    y = jnp.einsum('blgc,gce->blge', d, pool_w.astype(jnp.float32)).reshape(B, L, MIX_W)
    y = (y * pool_scale.astype(jnp.float32)).astype(u.dtype)
    return y, jnp.concatenate([buf, u], axis=1)[:, -POOL_BUF:]


def sink_softmax(s, valid, sink):
    s = jnp.where(valid, s.astype(jnp.float32), -jnp.inf)
    sk = sink.astype(jnp.float32)[..., None]
    m = jnp.maximum(jnp.max(s, axis=-1, keepdims=True), sk)
    e = jnp.exp(s - m)
    return e / (jnp.sum(e, axis=-1, keepdims=True) + jnp.exp(sk - m))


def swa_attention(q, k, v, sinks, k_buf, v_buf):
    B, L = q.shape[:2]
    scale = SWA_HEAD_DIM ** -0.5
    sink = sinks.reshape(SWA_KV_HEADS, SWA_GROUP)
    if k_buf is None:
        nb = L // WINDOW
        qb = q.reshape(B, nb, WINDOW, SWA_KV_HEADS, SWA_GROUP, SWA_HEAD_DIM)

        def band_keys(t):
            tb = t.reshape(B, nb, WINDOW, SWA_KV_HEADS, SWA_HEAD_DIM)
            prev = jnp.concatenate([jnp.zeros_like(tb[:, :1]), tb[:, :-1]], axis=1)
            return jnp.concatenate([prev, tb], axis=2)

        kk, vv = band_keys(k), band_keys(v)
        qi = jnp.arange(WINDOW)[:, None]
        ci = jnp.arange(2 * WINDOW)[None, :]
        band = (ci > qi) & (ci <= qi + WINDOW)
        not_first = jnp.arange(nb)[:, None, None] > 0
        valid = band[None] & (not_first | (ci >= WINDOW)[None])
        s = jnp.einsum('bnqkgd,bnckd->bnkgqc', qb, kk) * scale
        p = sink_softmax(s, valid[None, :, None, None], sink[None, None, :, :, None])
        o = jnp.einsum('bnkgqc,bnckd->bnqkgd', p.astype(v.dtype), vv).reshape(B, L, MIX_W)
        return o, k[:, -WINDOW:], v[:, -WINDOW:]
    kk = jnp.concatenate([k_buf.astype(k.dtype), k], axis=1)
    vv = jnp.concatenate([v_buf.astype(v.dtype), v], axis=1)
    qi = jnp.arange(L)[:, None]
    ci = jnp.arange(WINDOW + L)[None, :]
    valid = (ci > qi) & (ci <= qi + WINDOW)
    qg = q.reshape(B, L, SWA_KV_HEADS, SWA_GROUP, SWA_HEAD_DIM)
    s = jnp.einsum('bqkgd,bckd->bkgqc', qg, kk) * scale
    p = sink_softmax(s, valid, sink[None, :, :, None])
    o = jnp.einsum('bkgqc,bckd->bqkgd', p.astype(v.dtype), vv).reshape(B, L, MIX_W)
    return o, kk[:, -WINDOW:], vv[:, -WINDOW:]


def memory_kv(mem, mem_norm_g, w_mem_kv, mem_knorm_g):
    B, M, _ = mem.shape
    kv = rms_norm(mem, mem_norm_g) @ w_mem_kv
    k, v = jnp.split(kv, 2, axis=-1)
    k = rms_norm(k.reshape(B, M, MEM_HEADS, MEM_HEAD_DIM), mem_knorm_g)
    return k, v.reshape(B, M, MEM_HEADS, MEM_HEAD_DIM)


def mem_attention(q, mem_k, mem_v):
    B, L = q.shape[:2]
    s = jnp.einsum('blhd,bmhd->bhlm', q, mem_k.astype(q.dtype)) * MEM_HEAD_DIM ** -0.5
    p = jax.nn.softmax(s.astype(jnp.float32), axis=-1)
    o = jnp.einsum('bhlm,bmhd->blhd', p.astype(mem_v.dtype), mem_v)
    return o.reshape(B, L, MIX_W).astype(q.dtype)


def conv_ffn(m, conv_buf, w_up, conv_w, conv_b, w_down):
    L = m.shape[1]
    a, v = jnp.split(m @ w_up, 2, axis=-1)
    ext = jnp.concatenate([conv_buf.astype(a.dtype), a], axis=1)
    c = conv_b
    for j in range(CONV_W):
        c = c + conv_w[j] * ext[:, j:j + L]
    y = (jax.nn.gelu(c, approximate=False) * v) @ w_down
    return y, ext[:, -(CONV_W - 1):]


def layer_forward(x, pos, mem_k, mem_v, hgrn_s0, pool_buf, conv_buf, k_buf, v_buf, lb,
                  norm1_g, w_in, hgrn_norm_g, pool_w, pool_scale, swa_qnorm_g, swa_knorm_g,
                  swa_sinks, mem_qnorm_g, w_branch, w_o, norm2_g, w_up, conv_w, conv_b, w_down):
    B, L, _ = x.shape
    n = rms_norm(x, norm1_g)
    qa, fa, ia, ga, ub, qc, kc, vc, qm, gz = split_cols(n @ w_in)
    z = fa.reshape(B, L, A_HEADS, A_DK).astype(jnp.float32)
    lbh = lb.reshape(A_HEADS, A_DK)
    log_f = jnp.logaddexp(jnp.log(lbh), jnp.log1p(-lbh) + jax.nn.log_sigmoid(z))
    k_a = (1.0 - lbh) * jax.nn.sigmoid(-z)
    s_a, o_a = hgrn2_chunked(jax.nn.silu(qa.reshape(B, L, A_HEADS, A_DK)), k_a,
                             ia.reshape(B, L, A_HEADS, A_DV), log_f, hgrn_s0)
    y_a = rms_norm(o_a, hgrn_norm_g.reshape(A_HEADS, A_DV)) * \
        jax.nn.silu(ga.reshape(B, L, A_HEADS, A_DV).astype(jnp.float32))
    y_a = y_a.astype(x.dtype).reshape(B, L, MIX_W)
    y_b, pool_new = pool_mixer(ub, pool_buf, pos, pool_w, pool_scale)
    q_c = partial_rope(rms_norm(qc.reshape(B, L, SWA_Q_HEADS, SWA_HEAD_DIM), swa_qnorm_g), pos)
    k_c = partial_rope(rms_norm(kc.reshape(B, L, SWA_KV_HEADS, SWA_HEAD_DIM), swa_knorm_g), pos)
    v_c = vc.reshape(B, L, SWA_KV_HEADS, SWA_HEAD_DIM)
    y_c, k_new, v_new = swa_attention(q_c, k_c, v_c, swa_sinks, k_buf, v_buf)
    y_m = mem_attention(rms_norm(qm.reshape(B, L, MEM_HEADS, MEM_HEAD_DIM), mem_qnorm_g), mem_k, mem_v)
    branches = jnp.stack([y_a, y_b, y_c, y_m], axis=2)
    z_br = jnp.einsum('blnc,ncd->blnd', branches, w_branch)
    gates = jax.nn.sigmoid(gz.reshape(B, L, N_BRANCH, D_MODEL).astype(jnp.float32))
    merged = jnp.sum(gates * z_br.astype(jnp.float32), axis=2).astype(x.dtype)
    h = x + merged @ w_o
    y_f, conv_new = conv_ffn(rms_norm(h, norm2_g), conv_buf, w_up, conv_w, conv_b, w_down)
    return h + y_f, (s_a, pool_new, k_new, v_new, conv_new)


def setup_inputs(seed: int = 0) -> dict:
    key = jax.random.key(seed)
    ks = jax.random.split(key, 40)
    f32 = jnp.float32

    def nrm(i, shape, s=1.0):
        return jax.random.normal(ks[i], shape, f32) * s

    def gain(i, shape):
        return 1.0 + 0.1 * jax.random.normal(ks[i], shape, f32)

    return {
        "x_prompt": nrm(0, (BATCH, SEQ, D_MODEL)),
        "x_sample": nrm(1, (DEC_BATCH, DEC_SEQ, D_MODEL)),
        "mem_prompt": nrm(2, (BATCH, N_MEM, D_MODEL)),
        "state_hgrn": nrm(3, (DEPTH, DEC_BATCH, A_HEADS, A_DK, A_DV), 0.5),
        "cache_pool": nrm(4, (DEPTH, DEC_BATCH, POOL_BUF, MIX_W)),
        "cache_swa_k": nrm(5, (DEPTH, DEC_BATCH, WINDOW, SWA_KV_HEADS, SWA_HEAD_DIM)),
        "cache_swa_v": nrm(6, (DEPTH, DEC_BATCH, WINDOW, SWA_KV_HEADS, SWA_HEAD_DIM)),
        "state_conv": nrm(7, (DEPTH, DEC_BATCH, CONV_W - 1, D_FF)),
        "cache_mem_k": nrm(8, (DEPTH, DEC_BATCH, N_MEM, MEM_HEADS, MEM_HEAD_DIM)),
        "cache_mem_v": nrm(9, (DEPTH, DEC_BATCH, N_MEM, MEM_HEADS, MEM_HEAD_DIM)),
        "norm1_g": gain(10, (DEPTH, D_MODEL)),
        "w_in": nrm(11, (DEPTH, D_MODEL, IN_COLS), D_MODEL ** -0.5),
        "hgrn_lb": nrm(12, (DEPTH, MIX_W)),
        "hgrn_norm_g": gain(13, (DEPTH, MIX_W)),
        "pool_w": nrm(14, (DEPTH, POOL_GROUPS, POOL_GC, POOL_GC), POOL_GC ** -0.5),
        "pool_scale": gain(15, (DEPTH, MIX_W)),
        "swa_qnorm_g": gain(16, (DEPTH, SWA_HEAD_DIM)),
        "swa_knorm_g": gain(17, (DEPTH, SWA_HEAD_DIM)),
        "swa_sinks": nrm(18, (DEPTH, SWA_Q_HEADS)),
        "mem_norm_g": gain(19, (DEPTH, D_MODEL)),
        "w_mem_kv": nrm(20, (DEPTH, D_MODEL, 2 * MIX_W), D_MODEL ** -0.5),
        "mem_qnorm_g": gain(21, (DEPTH, MEM_HEAD_DIM)),
        "mem_knorm_g": gain(22, (DEPTH, MEM_HEAD_DIM)),
        "w_branch": nrm(23, (DEPTH, N_BRANCH, MIX_W, D_MODEL), MIX_W ** -0.5),
        "w_o": nrm(24, (DEPTH, D_MODEL, D_MODEL), D_MODEL ** -0.5),
        "norm2_g": gain(25, (DEPTH, D_MODEL)),
        "w_up": nrm(26, (DEPTH, D_MODEL, 2 * D_FF), D_MODEL ** -0.5),
        "conv_w": nrm(27, (DEPTH, CONV_W, D_FF), 0.5),
        "conv_b": nrm(28, (DEPTH, D_FF), 0.02),
        "w_down": nrm(29, (DEPTH, D_FF, D_MODEL), D_FF ** -0.5),
    }


def reference(x_prompt, x_sample, mem_prompt, state_hgrn, cache_pool, cache_swa_k, cache_swa_v,
              state_conv, cache_mem_k, cache_mem_v, norm1_g, w_in, hgrn_lb, hgrn_norm_g, pool_w,
              pool_scale, swa_qnorm_g, swa_knorm_g, swa_sinks, mem_norm_g, w_mem_kv, mem_qnorm_g,
              mem_knorm_g, w_branch, w_o, norm2_g, w_up, conv_w, conv_b, w_down):
    lb_all = jnp.cumsum(jax.nn.softmax(hgrn_lb.astype(jnp.float32), axis=0), axis=0)
    lb_all = lb_all - lb_all[:1]
    pos_p = jnp.arange(x_prompt.shape[1], dtype=jnp.int32)
    pos_s = PAST_LEN + jnp.arange(x_sample.shape[1], dtype=jnp.int32)
    bp = x_prompt.shape[0]
    xp, xs = x_prompt, x_sample
    st_p, st_s, mks, mvs = [], [], [], []
    for l in range(DEPTH):
        lw = (norm1_g[l], w_in[l], hgrn_norm_g[l], pool_w[l], pool_scale[l], swa_qnorm_g[l],
              swa_knorm_g[l], swa_sinks[l], mem_qnorm_g[l], w_branch[l], w_o[l], norm2_g[l],
              w_up[l], conv_w[l], conv_b[l], w_down[l])
        mk, mv = memory_kv(mem_prompt, mem_norm_g[l], w_mem_kv[l], mem_knorm_g[l])
        mks.append(mk)
        mvs.append(mv)
        xp, sp = layer_forward(
            xp, pos_p, mk, mv,
            jnp.zeros((bp, A_HEADS, A_DK, A_DV), jnp.float32),
            jnp.zeros((bp, POOL_BUF, MIX_W), xp.dtype),
            jnp.zeros((bp, CONV_W - 1, D_FF), xp.dtype),
            None, None, lb_all[l], *lw)
        xs, ss = layer_forward(
            xs, pos_s, cache_mem_k[l], cache_mem_v[l], state_hgrn[l], cache_pool[l], state_conv[l],
            cache_swa_k[l], cache_swa_v[l], lb_all[l], *lw)
        st_p.append(sp)
        st_s.append(ss)

    def stk(sts, i):
        return jnp.stack([s[i] for s in sts], axis=0)

    return (xp, xs,
            stk(st_p, 0), stk(st_s, 0),
            stk(st_p, 1), stk(st_s, 1),
            stk(st_p, 2), stk(st_s, 2),
            stk(st_p, 3), stk(st_s, 3),
            stk(st_p, 4), stk(st_s, 4),
            jnp.stack(mks, axis=0), jnp.stack(mvs, axis=0))
```

```cpp
#ifdef EMU
#include "emu.h"
#else
#include <hip/hip_runtime.h>
#endif
#include <cstdio>
#include <cstdint>

#ifndef CFG_SEQ
#define CFG_SEQ 8192
#endif
#ifndef CFG_DECB
#define CFG_DECB 128
#endif
#ifndef MK_N_LAUNCHES
#define MK_N_LAUNCHES 0
#endif

constexpr int SEQ = CFG_SEQ, DECB = CFG_DECB, NS = DECB * 4, M = SEQ + NS, NPAN = M / 256, NPP = SEQ / 256;
constexpr int DM = 2048, MIXW = 1024, INC = 15872, DFF = 5632, NMEM = 256, DEPTH = 2;
constexpr int C_QA = 0, C_FA = 1024, C_IA = 2048, C_GA = 3072, C_UB = 4096, C_QC = 5120, C_KC = 6144, C_VC = 6400, C_QM = 6656, C_GZ = 7680;
constexpr int NSC = SEQ / 128;
constexpr int PAST_LEN = 8192;
constexpr float EPS = 1e-6f;
static_assert(SEQ % 256 == 0 && NS % 256 == 0, "row panels");

constexpr size_t O_Y = 0;
constexpr size_t O_HSP = (size_t)M * DM;
constexpr size_t O_HSS = O_HSP + (size_t)DEPTH * 8 * 16384;
constexpr size_t O_PLP = O_HSS + (size_t)DEPTH * DECB * 8 * 16384;
constexpr size_t O_PLS = O_PLP + (size_t)DEPTH * 15 * 1024;
constexpr size_t O_KP = O_PLS + (size_t)DEPTH * DECB * 15 * 1024;
constexpr size_t O_KS = O_KP + (size_t)DEPTH * 128 * 256;
constexpr size_t O_VP = O_KS + (size_t)DEPTH * DECB * 128 * 256;
constexpr size_t O_VS = O_VP + (size_t)DEPTH * 128 * 256;
constexpr size_t O_CVP = O_VS + (size_t)DEPTH * DECB * 128 * 256;
constexpr size_t O_CVS = O_CVP + (size_t)DEPTH * 2 * DFF;
constexpr size_t O_MKP = O_CVS + (size_t)DEPTH * DECB * 2 * DFF;
constexpr size_t O_MVP = O_MKP + (size_t)DEPTH * 256 * 1024;
constexpr size_t O_END = O_MVP + (size_t)DEPTH * 256 * 1024;

constexpr size_t al(size_t x) { return (x + 4095) & ~(size_t)4095; }
constexpr size_t WS_CTL = 0, CTL_BYTES = (size_t)1 << 20;
constexpr size_t WS_ROWSUM = WS_CTL + CTL_BYTES, ROWSUM_BYTES = al((size_t)DEPTH * SEQ * 4 * 4);
constexpr size_t ZERO_BYTES = CTL_BYTES + ROWSUM_BYTES;
constexpr size_t WS_TAB = WS_ROWSUM + ROWSUM_BYTES;
constexpr size_t T_LB = 0, T_COSP = 2048, T_SINP = T_COSP + (size_t)SEQ * 8, T_COSS = T_SINP + (size_t)SEQ * 8, T_SINS = T_COSS + 32, T_END = T_SINS + 32;
constexpr size_t WS_WIN = al(WS_TAB + T_END * 4);
constexpr size_t WIN0_ROWS = INC + 2 * 2048;
constexpr size_t WS_WIN1 = al(WS_WIN + WIN0_ROWS * DM * 2);
constexpr size_t WS_WBR = al(WS_WIN1 + (size_t)INC * DM * 2);
constexpr size_t WS_WO = al(WS_WBR + (size_t)DEPTH * 8192 * 1024 * 2);
constexpr size_t WS_WUP = al(WS_WO + (size_t)DEPTH * DM * DM * 2);
constexpr size_t WS_WDN = al(WS_WUP + (size_t)DEPTH * 2 * DFF * DM * 2);
constexpr size_t WS_WPL = al(WS_WDN + (size_t)DEPTH * DM * DFF * 2);
constexpr size_t WS_XN = al(WS_WPL + (size_t)DEPTH * 1024 * 256 * 2);
constexpr size_t WS_P = al(WS_XN + (size_t)(M + 512) * DM * 2);
constexpr size_t WS_LOGF = al(WS_P + (size_t)M * INC * 2);
constexpr size_t WS_OLOC = al(WS_LOGF + (size_t)M * 1024 * 4);
constexpr size_t WS_U = al(WS_OLOC + (size_t)SEQ * 1024 * 4);
constexpr size_t WS_DTOT = al(WS_U + (size_t)NSC * 8 * 16384 * 4);
constexpr size_t WS_SIN = al(WS_DTOT + (size_t)NSC * 8 * 128 * 4);
constexpr size_t WS_D = al(WS_SIN + (size_t)NSC * 8 * 16384 * 2);
constexpr size_t WS_E = al(WS_D + (size_t)M * 1024 * 2);
constexpr size_t WS_Y = al(WS_E + (size_t)SEQ * 1024 * 2);
constexpr size_t WS_MACC = al(WS_Y + (size_t)M * 4096 * 2);
constexpr size_t WS_MERGED = al(WS_MACC + (size_t)M * DM * 4);
constexpr size_t WS_ACT = al(WS_MERGED + (size_t)M * DM * 2);
constexpr size_t WS_KVRAW = al(WS_ACT + (size_t)M * DFF * 2);
constexpr size_t WS_KMEM = al(WS_KVRAW + (size_t)256 * 4096 * 4);
constexpr size_t WS_VMEMT = al(WS_KMEM + (size_t)DEPTH * 1024 * 256 * 2);
constexpr size_t WS_END = al(WS_VMEMT + (size_t)DEPTH * 1024 * 256 * 2);

#ifdef EMU
#define LAS
#define ASMV(x)
#define WAVE_LDS_FENCE() emu_wave_sync()
#else
#define LAS __attribute__((address_space(3)))
#define ASMV(x) asm volatile(x ::: "memory")
#define WAVE_LDS_FENCE() asm volatile("s_waitcnt lgkmcnt(0)" ::: "memory")
#endif
#ifdef EMU
#define OPQ_V(x)
#define OPQ_S(x)
#else
#define OPQ_V(x) asm volatile("" : "+v"(x))
#define OPQ_S(x) asm volatile("" : "+s"(x))
#endif
typedef unsigned short bf16;
typedef unsigned v4u __attribute__((ext_vector_type(4)));
typedef unsigned v2u __attribute__((ext_vector_type(2)));
typedef float f32x4 __attribute__((ext_vector_type(4)));
typedef float f32x2 __attribute__((ext_vector_type(2)));
typedef short bf16x8 __attribute__((ext_vector_type(8)));
constexpr int NT = 512, NWAVES = 8;
__device__ __forceinline__ unsigned f2bf(float f) { unsigned u = __builtin_bit_cast(unsigned, f); return (u + 0x7fffu + ((u >> 16) & 1u)) >> 16; }
__device__ __forceinline__ float bf2f(unsigned b) { return __builtin_bit_cast(float, b << 16); }
__device__ __forceinline__ unsigned pk2(float lo, float hi) { return f2bf(lo) | (f2bf(hi) << 16); }
__device__ __forceinline__ float bflo(unsigned w) { return __builtin_bit_cast(float, w << 16); }
__device__ __forceinline__ float bfhi(unsigned w) { return __builtin_bit_cast(float, w & 0xffff0000u); }
__device__ __forceinline__ void unpack8(v4u w, float (&f)[8]) { f[0] = bflo(w.x); f[1] = bfhi(w.x); f[2] = bflo(w.y); f[3] = bfhi(w.y); f[4] = bflo(w.z); f[5] = bfhi(w.z); f[6] = bflo(w.w); f[7] = bfhi(w.w); }
__device__ __forceinline__ v4u pack8(const float (&f)[8]) { v4u w; w.x = pk2(f[0], f[1]); w.y = pk2(f[2], f[3]); w.z = pk2(f[4], f[5]); w.w = pk2(f[6], f[7]); return w; }
__device__ __forceinline__ float wave_sum(float v) {
#pragma unroll
    for (int o = 1; o < 64; o <<= 1) v += __shfl_xor(v, o);
    return v;
}
__device__ __forceinline__ float sigmoidf_(float x) { return 1.0f / (1.0f + __expf(-x)); }
__device__ __forceinline__ float siluf_(float x) { return x / (1.0f + __expf(-x)); }
__device__ __forceinline__ float gelu_as(float v) {
    const float av = fabsf(v), t = 1.0f / (av * 0.2316418882f + 1.0f);
    float q = t * 0.5307027145f + (-0.7265760135f); q = q * t + 0.7107068705f; q = q * t + (-0.142248368f); q = q * t + 0.127414796f; q = q * t;
    const float e = exp2f((v * v) * (-0.72134752044f)), m = v * (q * e);
    return v < 0.f ? m : v - m;
}
#ifdef EMU
__device__ __forceinline__ unsigned cvt_pk_bf16(float lo, float hi) { return pk2(lo, hi); }
#else
__device__ __forceinline__ unsigned cvt_pk_bf16(float lo, float hi) { unsigned r; asm volatile("v_cvt_pk_bf16_f32 %0, %1, %2" : "=v"(r) : "v"(lo), "v"(hi)); return r; }
#endif

namespace pg8 {
constexpr int BM = 256, BK = 64, HALF = 128, HTB = HALF * BK * 2, STAGE_BYTES = 8 * HTB, NXCD = 8, WGM = 8;
__host__ __device__ __forceinline__ int lds_byte(int r, int c) { const int st = (r >> 4) * 2 + (c >> 5), rr = r & 15, cc = c & 31, ob = rr * 64 + cc * 2; return st * 1024 + (ob ^ (((ob >> 9) & 1) << 5)); }
__host__ __device__ __forceinline__ void stage_rc(int b, int& R, int& C) { const int st = b / 1024, sb = b % 1024, swz = sb ^ (((sb >> 9) & 1) << 5); R = (st >> 1) * 16 + swz / 64; C = (st & 1) * 32 + (swz % 64) / 2; }
__host__ __device__ __forceinline__ int perm32(int rho) { const int n = rho >> 4, i = rho & 15; return 8 * (i >> 2) + 4 * n + (i & 3); }
struct Unit { int pm, pn, acol; };
struct Gemm { const bf16* A; const bf16* Bt; int lda, ldb, K; };
__device__ __forceinline__ bool grid_order(int L, int nM, int nN, int& pm, int& pn) {
    const int nwg = nM * nN; if (L >= nwg) return false;
    int wgid = L; { const int q = nwg / NXCD, r = nwg % NXCD, xcd = wgid % NXCD, off = wgid / NXCD; wgid = (xcd < r ? xcd * (q + 1) : r * (q + 1) + (xcd - r) * q) + off; }
    const int nig = WGM * nN, gid = wgid / nig, fm = gid * WGM, gsz = (nM - fm) < WGM ? (nM - fm) : WGM;
    pm = fm + ((wgid % nig) % gsz); pn = (wgid % nig) / gsz; return true;
}
struct SchedGrid {
    int nM, nN, G, c, acol_step;
    __device__ __forceinline__ bool next(int i, Unit& u) const { const long L = (long)i * G + c; if (L >= (long)nM * nN) return false; if (!grid_order((int)L, nM, nN, u.pm, u.pn)) return false; u.acol = u.pn * acol_step; return true; }
};
struct SchedIn {
    int nM, nN, G, c, nextra;
    __device__ __forceinline__ bool next(int i, Unit& u) const { const long L = (long)i * G + c; u.acol = 0;
        if (L < (long)nM * nN) return grid_order((int)L, nM, nN, u.pm, u.pn);
        const int x = (int)(L - (long)nM * nN); if (x >= nextra) return false; u.pm = nM + x / 8; u.pn = nN + x; return true; }
};
struct SchedBranch {
    int nM, G, c;
    __device__ __forceinline__ bool next(int i, Unit& u) const { const long su = (long)(i >> 2) * G + c; int pm, pd; if (su >= (long)nM * 8) return false; if (!grid_order((int)su, nM, 8, pm, pd)) return false;
        const int n = i & 3; u.pm = pm; u.pn = n * 8 + pd; u.acol = n * 1024; return true; }
};

#ifdef EMU
static float emu_C[256 * 256];
static void emu_tile(const Gemm& g, const Unit& u) {
    static std::vector<float> Af, Bf; Af.resize((size_t)256 * g.K); Bf.resize((size_t)256 * g.K);
    for (int r = 0; r < 256; ++r) for (int k = 0; k < g.K; ++k) { Af[(size_t)r * g.K + k] = bf2f(g.A[(size_t)(256 * u.pm + r) * g.lda + u.acol + k]); Bf[(size_t)r * g.K + k] = bf2f(g.Bt[(size_t)(256 * u.pn + r) * g.ldb + k]); }
#pragma omp parallel for
    for (int r = 0; r < 256; ++r) for (int c = 0; c < 256; ++c) { const float* a = &Af[(size_t)r * g.K]; const float* b = &Bf[(size_t)c * g.K]; float s = 0.f; for (int k = 0; k < g.K; ++k) s += a[k] * b[k]; emu_C[r * 256 + c] = s; }
}
template <class Epi, class Sched>
void gemm_phase(unsigned char* lds, const Gemm g, const Sched& S, const Epi& E) {
    const int tid = threadIdx.x, wid = tid >> 6, lane = tid & 63, wr = wid >> 2, wc = wid & 3, fr = lane & 15, fq = lane >> 4;
    for (int i = 0;; ++i) { Unit u; if (!S.next(i, u)) break;
        __syncthreads(); if (tid == 0) emu_tile(g, u); __syncthreads();
        f32x4 acc[2][2][4][2];
        for (int ai = 0; ai < 2; ++ai) for (int bj = 0; bj < 2; ++bj) for (int m = 0; m < 4; ++m) for (int n = 0; n < 2; ++n) for (int x = 0; x < 4; ++x) {
            const int row = 128 * ai + 64 * wr + 16 * m + fr, col = Epi::PERM ? 128 * bj + 32 * wc + 8 * fq + 4 * n + x : 128 * bj + 32 * wc + 16 * n + 4 * fq + x; acc[ai][bj][m][n][x] = emu_C[row * 256 + col]; }
        E(acc, u, wr, wc, fr, fq); }
    __syncthreads();
}
#else
template <class Epi, class Sched>
__device__ __forceinline__ void gemm_phase(LAS unsigned char* lds, const Gemm g, const Sched& S, const Epi& E) {
    int tid = threadIdx.x; OPQ_V(tid); const int wid = __builtin_amdgcn_readfirstlane(tid >> 6), lane = tid & 63, wr = wid >> 2, wc = wid & 3, fr = lane & 15, fq = lane >> 4;
    int K = g.K; asm volatile("" : "+s"(K)); const int nt = K / BK;
    unsigned voffA[2], voffB[2];
#pragma unroll
    for (int i = 0; i < 2; ++i) { int R, C; stage_rc(tid * 16 + i * 8192, R, C); const int Rb = Epi::PERM ? ((R & ~31) + perm32(R & 31)) : R;
        voffA[i] = (unsigned)(R * g.lda + C) * 2u; voffB[i] = (unsigned)(Rb * g.ldb + C) * 2u; }
    const size_t kstep = (size_t)(BK * 2);
    const size_t hstepA = (size_t)HALF * g.lda * 2, hstepB = (size_t)HALF * g.ldb * 2;
    const unsigned ldsw = (unsigned)wid * 1024u;
    const int aoff = lds_byte(wr * 64 + fr, fq * 8), boff = lds_byte(wc * 32 + fr, fq * 8);
#define PG8_SA(b, h) (((b) * 2 + (h)) * HTB)
#define PG8_SB(b, h) ((4 + (b) * 2 + (h)) * HTB)
#define PG8_STAGE(bufoff, gbase, voff) do { _Pragma("unroll") for (int _i = 0; _i < 2; ++_i) \
        __builtin_amdgcn_global_load_lds((const unsigned*)((const char*)(gbase) + (voff)[_i]), (LAS unsigned*)(lds + (bufoff) + ldsw + _i * 8192), 16, 0, 0); } while (0)
#define PG8_LDA(dst, b, h) do { _Pragma("unroll") for (int m = 0; m < 4; ++m) _Pragma("unroll") for (int k = 0; k < 2; ++k) dst[m][k] = *(const LAS bf16x8*)(lds + PG8_SA(b, h) + aoff + m * 2048 + k * 1024); } while (0)
#define PG8_LDB(dst, b, h) do { _Pragma("unroll") for (int n = 0; n < 2; ++n) _Pragma("unroll") for (int k = 0; k < 2; ++k) dst[n][k] = *(const LAS bf16x8*)(lds + PG8_SB(b, h) + boff + n * 2048 + k * 1024); } while (0)
#define PG8_MMA(ai, bj, At, Bt) do { __builtin_amdgcn_s_setprio(1); _Pragma("unroll") for (int m = 0; m < 4; ++m) _Pragma("unroll") for (int n = 0; n < 2; ++n) _Pragma("unroll") for (int k = 0; k < 2; ++k) \
        acc[ai][bj][m][n] = __builtin_amdgcn_mfma_f32_16x16x32_bf16(Bt[n][k], At[m][k], acc[ai][bj][m][n], 0, 0, 0); __builtin_amdgcn_s_setprio(0); } while (0)
#define PG8_WAIT_V(n) asm volatile("s_waitcnt vmcnt(" #n ")" ::: "memory")
#define PG8_WAIT_L(n) asm volatile("s_waitcnt lgkmcnt(" #n ")" ::: "memory")
#define PG8_BAR __builtin_amdgcn_s_barrier()
#define PG8_SCHED __builtin_amdgcn_sched_barrier(0)
    Unit cur, nxt; int ui = 0;
    if (!S.next(0, cur)) return;
    f32x4 acc[2][2][4][2];
#pragma unroll
    for (int a = 0; a < 2; ++a)
#pragma unroll
        for (int b = 0; b < 2; ++b)
#pragma unroll
            for (int m = 0; m < 4; ++m)
#pragma unroll
                for (int n = 0; n < 2; ++n) acc[a][b][m][n] = (f32x4){0.f, 0.f, 0.f, 0.f};
    bf16x8 At[4][2], B0[2][2], B1[2][2];
    const char* cA = (const char*)g.A + ((size_t)cur.pm * 256 * g.lda + cur.acol) * 2; const char* cB = (const char*)g.Bt + (size_t)cur.pn * 256 * g.ldb * 2;
    PG8_STAGE(PG8_SB(0, 0), cB, voffB); PG8_STAGE(PG8_SA(0, 0), cA, voffA); PG8_STAGE(PG8_SB(0, 1), cB + hstepB, voffB); PG8_STAGE(PG8_SA(0, 1), cA + hstepA, voffA);
    if (wr == 1) PG8_BAR;
    PG8_WAIT_V(4); PG8_BAR;
    PG8_STAGE(PG8_SB(1, 0), cB + kstep, voffB); PG8_STAGE(PG8_SA(1, 0), cA + kstep, voffA); PG8_STAGE(PG8_SB(1, 1), cB + hstepB + kstep, voffB);
    PG8_WAIT_V(6); PG8_BAR;
    for (;;) {
        const bool has_next = S.next(ui + 1, nxt);
        const char* nA = has_next ? (const char*)g.A + ((size_t)nxt.pm * 256 * g.lda + nxt.acol) * 2 : cA; const char* nB = has_next ? (const char*)g.Bt + (size_t)nxt.pn * 256 * g.ldb * 2 : cB;
        for (int t = 0; t < nt; t += 2) {
            const bool last = (t == nt - 2);
            const char* a1 = cA + (size_t)(t + 1) * kstep;
            const char* a2 = last ? nA : cA + (size_t)(t + 2) * kstep; const char* b2 = last ? nB : cB + (size_t)(t + 2) * kstep;
            const char* a3 = a2 + kstep; const char* b3 = b2 + kstep;
            PG8_LDB(B0, 0, 0); PG8_SCHED; PG8_LDA(At, 0, 0); PG8_STAGE(PG8_SA(1, 1), a1 + hstepA, voffA);
            PG8_WAIT_L(8); PG8_BAR; PG8_WAIT_L(0); PG8_MMA(0, 0, At, B0); PG8_BAR; PG8_SCHED;
            PG8_LDB(B1, 0, 1); PG8_STAGE(PG8_SB(0, 0), b2, voffB);
            PG8_BAR; PG8_WAIT_L(0); PG8_MMA(0, 1, At, B1); PG8_BAR;
            PG8_LDA(At, 0, 1); PG8_STAGE(PG8_SA(0, 0), a2, voffA);
            PG8_BAR; PG8_WAIT_L(0); PG8_MMA(1, 0, At, B0); PG8_BAR; PG8_SCHED;
            PG8_STAGE(PG8_SB(0, 1), b2 + hstepB, voffB);
            PG8_WAIT_V(6); PG8_BAR; PG8_MMA(1, 1, At, B1); PG8_BAR;
            PG8_LDB(B0, 1, 0); PG8_SCHED; PG8_LDA(At, 1, 0); PG8_STAGE(PG8_SA(0, 1), a2 + hstepA, voffA);
            PG8_WAIT_L(8); PG8_BAR; PG8_WAIT_L(0); PG8_MMA(0, 0, At, B0); PG8_BAR; PG8_SCHED;
            PG8_LDB(B1, 1, 1); PG8_STAGE(PG8_SB(1, 0), b3, voffB);
            PG8_BAR; PG8_WAIT_L(0); PG8_MMA(0, 1, At, B1); PG8_BAR;
            PG8_LDA(At, 1, 1); PG8_STAGE(PG8_SA(1, 0), a3, voffA);
            PG8_BAR; PG8_WAIT_L(0); PG8_MMA(1, 0, At, B0); PG8_BAR; PG8_SCHED;
            PG8_STAGE(PG8_SB(1, 1), b3 + hstepB, voffB);
            PG8_WAIT_V(6); PG8_BAR; PG8_MMA(1, 1, At, B1); PG8_BAR;
        }
        E(acc, cur, wr, wc, fr, fq);
        if (!has_next) break;
#pragma unroll
        for (int a = 0; a < 2; ++a)
#pragma unroll
            for (int b = 0; b < 2; ++b)
#pragma unroll
                for (int m = 0; m < 4; ++m)
#pragma unroll
                    for (int n = 0; n < 2; ++n) acc[a][b][m][n] = (f32x4){0.f, 0.f, 0.f, 0.f};
        cur = nxt; cA = nA; cB = nB; ++ui;
    }
    PG8_WAIT_V(0);
    if (wr == 0) PG8_BAR;
    PG8_BAR;
#undef PG8_SA
#undef PG8_SB
#undef PG8_STAGE
#undef PG8_LDA
#undef PG8_LDB
#undef PG8_MMA
#undef PG8_WAIT_V
#undef PG8_WAIT_L
#undef PG8_BAR
#undef PG8_SCHED
}
#endif
typedef f32x4 Acc[2][2][4][2];
struct EpiIn {
    static constexpr bool PERM = true;
    bf16* P; float* LOGF; const float* lb; float* KVRAW;
    __device__ __forceinline__ void operator()(const Acc& acc, const Unit& u, int wr, int wc, int fr, int fq) const {
        const int rl = wr * 64 + fr, cl = wc * 32 + 8 * fq;
        if (u.pn >= INC / 256) {
            const int cb = (u.pn - INC / 256) * 256 + cl;
#pragma unroll
            for (int ai = 0; ai < 2; ++ai)
#pragma unroll
                for (int m = 0; m < 4; ++m) { float* rp = KVRAW + (size_t)(rl + ai * 128 + m * 16) * 4096 + cb;
#pragma unroll
                    for (int bj = 0; bj < 2; ++bj) { *(f32x4*)(rp + bj * 128) = acc[ai][bj][m][0]; *(f32x4*)(rp + bj * 128 + 4) = acc[ai][bj][m][1]; } }
            return;
        }
        const int pn = u.pn; const int kind = (pn < 4) ? 1 : (pn < 8) ? 3 : (pn < 12) ? 0 : (pn < 16) ? 1 : (pn < 30) ? 0 : 2;
        const int row0 = u.pm * 256 + rl, col0 = pn * 256 + cl;
        if (kind == 3) {
            f32x4 l0[2], l1[2];
#pragma unroll
            for (int bj = 0; bj < 2; ++bj) { l0[bj] = *(const f32x4*)(lb + col0 - C_FA + bj * 128); l1[bj] = *(const f32x4*)(lb + col0 - C_FA + bj * 128 + 4); }
#pragma unroll
            for (int ai = 0; ai < 2; ++ai)
#pragma unroll
                for (int m = 0; m < 4; ++m) { float* rp = LOGF + (size_t)(row0 + ai * 128 + m * 16) * 1024 + (col0 - C_FA);
#pragma unroll
                    for (int bj = 0; bj < 2; ++bj) { f32x4 o0, o1;
#pragma unroll
                        for (int x = 0; x < 4; ++x) { o0[x] = logf(l0[bj][x] + (1.f - l0[bj][x]) * sigmoidf_(acc[ai][bj][m][0][x])); o1[x] = logf(l1[bj][x] + (1.f - l1[bj][x]) * sigmoidf_(acc[ai][bj][m][1][x])); }
                        *(f32x4*)(rp + bj * 128) = o0; *(f32x4*)(rp + bj * 128 + 4) = o1; } }
            return;
        }
#pragma unroll
        for (int ai = 0; ai < 2; ++ai)
#pragma unroll
            for (int m = 0; m < 4; ++m) { bf16* rp = P + (size_t)(row0 + ai * 128 + m * 16) * INC + col0;
#pragma unroll
                for (int bj = 0; bj < 2; ++bj) { f32x4 v0 = acc[ai][bj][m][0], v1 = acc[ai][bj][m][1];
                    if (kind == 1) {
#pragma unroll
                        for (int x = 0; x < 4; ++x) { v0[x] = siluf_(v0[x]); v1[x] = siluf_(v1[x]); } }
                    if (kind == 2) {
#pragma unroll
                        for (int x = 0; x < 4; ++x) { v0[x] = sigmoidf_(v0[x]); v1[x] = sigmoidf_(v1[x]); } }
                    v4u w; w.x = cvt_pk_bf16(v0[0], v0[1]); w.y = cvt_pk_bf16(v0[2], v0[3]); w.z = cvt_pk_bf16(v1[0], v1[1]); w.w = cvt_pk_bf16(v1[2], v1[3]);
                    *(v4u*)(rp + bj * 128) = w; } }
    }
};
struct EpiBf16S {
    static constexpr bool PERM = true;
    bf16* O; int ldc, cbase, cstep; const float* colscale; const float* rowsum; int rs_stride;
    __device__ __forceinline__ void operator()(const Acc& acc, const Unit& u, int wr, int wc, int fr, int fq) const {
        const int row0 = u.pm * 256 + wr * 64 + fr, cl = wc * 32 + 8 * fq, col0 = cbase + u.pn * cstep + cl;
        f32x4 s0[2], s1[2];
#pragma unroll
        for (int bj = 0; bj < 2; ++bj) { if (colscale) { s0[bj] = *(const f32x4*)(colscale + u.pn * 256 + cl + bj * 128); s1[bj] = *(const f32x4*)(colscale + u.pn * 256 + cl + bj * 128 + 4); } else { s0[bj] = (f32x4){1.f, 1.f, 1.f, 1.f}; s1[bj] = s0[bj]; } }
#pragma unroll
        for (int ai = 0; ai < 2; ++ai)
#pragma unroll
            for (int m = 0; m < 4; ++m) { const int row = row0 + ai * 128 + m * 16; bf16* rp = O + (size_t)row * ldc + col0;
                const float rs = rowsum ? 1.0f / rowsum[(size_t)row * rs_stride + u.pn] : 1.0f;
#pragma unroll
                for (int bj = 0; bj < 2; ++bj) { const f32x4 v0 = acc[ai][bj][m][0] * s0[bj] * rs, v1 = acc[ai][bj][m][1] * s1[bj] * rs;
                    v4u w; w.x = cvt_pk_bf16(v0[0], v0[1]); w.y = cvt_pk_bf16(v0[2], v0[3]); w.z = cvt_pk_bf16(v1[0], v1[1]); w.w = cvt_pk_bf16(v1[2], v1[3]);
                    *(v4u*)(rp + bj * 128) = w; } }
    }
};
struct EpiMemS {
    static constexpr bool PERM = true;
    bf16* E; float* rowsum;
    __device__ __forceinline__ void operator()(const Acc& acc, const Unit& u, int wr, int wc, int fr, int fq) const {
        const int row0 = u.pm * 256 + wr * 64 + fr, col0 = u.pn * 256 + wc * 32 + 8 * fq;
#pragma unroll
        for (int ai = 0; ai < 2; ++ai)
#pragma unroll
            for (int m = 0; m < 4; ++m) { const int row = row0 + ai * 128 + m * 16; bf16* rp = E + (size_t)row * 1024 + col0; float s = 0.f;
#pragma unroll
                for (int bj = 0; bj < 2; ++bj) { f32x4 v0, v1;
#pragma unroll
                    for (int x = 0; x < 4; ++x) { v0[x] = __expf(acc[ai][bj][m][0][x]); v1[x] = __expf(acc[ai][bj][m][1][x]); }
                    s += (v0[0] + v0[1]) + (v0[2] + v0[3]) + (v1[0] + v1[1]) + (v1[2] + v1[3]);
                    v4u w; w.x = cvt_pk_bf16(v0[0], v0[1]); w.y = cvt_pk_bf16(v0[2], v0[3]); w.z = cvt_pk_bf16(v1[0], v1[1]); w.w = cvt_pk_bf16(v1[2], v1[3]);
                    *(v4u*)(rp + bj * 128) = w; }
                s += __shfl_xor(s, 16); s += __shfl_xor(s, 32);
                if (fq == 0) atomicAdd(rowsum + (size_t)row * 4 + u.pn, s); }
    }
};
struct EpiBranch {
    static constexpr bool PERM = true;
    const bf16* P; float* MACC; bf16* MERGED;
    __device__ __forceinline__ void operator()(const Acc& acc, const Unit& u, int wr, int wc, int fr, int fq) const {
        const int n = u.pn >> 3, pd = u.pn & 7; const int row0 = u.pm * 256 + wr * 64 + fr, col0 = pd * 256 + wc * 32 + 8 * fq;
#pragma unroll
        for (int ai = 0; ai < 2; ++ai)
#pragma unroll
            for (int m = 0; m < 4; ++m) { const int row = row0 + ai * 128 + m * 16;
#pragma unroll
                for (int bj = 0; bj < 2; ++bj) { float g[8]; unpack8(*(const v4u*)(P + (size_t)row * INC + C_GZ + n * 2048 + col0 + bj * 128), g);
                    float* mp = MACC + (size_t)row * DM + col0 + bj * 128;
                    f32x4 v0 = acc[ai][bj][m][0], v1 = acc[ai][bj][m][1];
#pragma unroll
                    for (int x = 0; x < 4; ++x) { v0[x] *= g[x]; v1[x] *= g[4 + x]; }
                    if (n > 0) { v0 += *(const f32x4*)mp; v1 += *(const f32x4*)(mp + 4); }
                    if (n < 3) { *(f32x4*)mp = v0; *(f32x4*)(mp + 4) = v1; }
                    else { v4u w; w.x = cvt_pk_bf16(v0[0], v0[1]); w.y = cvt_pk_bf16(v0[2], v0[3]); w.z = cvt_pk_bf16(v1[0], v1[1]); w.w = cvt_pk_bf16(v1[2], v1[3]);
                        *(v4u*)(MERGED + (size_t)row * DM + col0 + bj * 128) = w; } } }
    }
};
struct EpiRes {
    static constexpr bool PERM = false;
    const float* res_p; const float* res_s; float* out;
    __device__ __forceinline__ void operator()(const Acc& acc, const Unit& u, int wr, int wc, int fr, int fq) const {
        const int row0 = u.pm * 256 + wr * 64 + fr, col0 = u.pn * 256 + wc * 32 + 4 * fq;
        const float* rbase = (u.pm * 256 < SEQ) ? res_p : res_s - (size_t)SEQ * DM;
#pragma unroll
        for (int ai = 0; ai < 2; ++ai)
#pragma unroll
            for (int m = 0; m < 4; ++m) { const size_t off = (size_t)(row0 + ai * 128 + m * 16) * DM + col0;
#pragma unroll
                for (int bj = 0; bj < 2; ++bj)
#pragma unroll
                    for (int n = 0; n < 2; ++n) { const f32x4 r = *(const f32x4*)(rbase + off + bj * 128 + n * 16); *(f32x4*)(out + off + bj * 128 + n * 16) = r + acc[ai][bj][m][n]; } }
    }
};
}

#ifndef EMU
#define XB_TMO      128
#define XB_XCNT(j)  (256  + 64 * (j))
#define XB_XSUB(j)  (1280 + 64 * (j))
#define XB_XGEN(j)  (2304 + 64 * (j))
#define XB_TOP      3328
#define XB_TOPGEN   3392
#define XCD_BAR_WORDS 3456
#define XB_SPIN_CAP (1u << 18)
__device__ __forceinline__ unsigned xb_ld(unsigned* p)              { return __hip_atomic_load(p, __ATOMIC_RELAXED, __HIP_MEMORY_SCOPE_AGENT); }
__device__ __forceinline__ unsigned xb_add(unsigned* p, unsigned v) { return __hip_atomic_fetch_add(p, v, __ATOMIC_RELAXED, __HIP_MEMORY_SCOPE_AGENT); }
__device__ __forceinline__ unsigned xb_xcc_id() { return (unsigned)__builtin_amdgcn_s_getreg((3 << 11) | 20) & 0xFu; }
#define XB_SPIN(cond, bar) do { unsigned _sp = 0; while (cond) { __builtin_amdgcn_s_sleep(1); \
    if ((++_sp & 255u) == 0u) { if (xb_ld(&(bar)[XB_TMO])) break; if (_sp > XB_SPIN_CAP) { atomicAdd(&(bar)[XB_TMO], 1u); break; } } } } while (0)
struct XcdBarrier { unsigned* bar; unsigned x; volatile LAS unsigned* st; };
__device__ __forceinline__ XcdBarrier xcd_barrier_post(unsigned* bar, volatile LAS unsigned* st) {
    XcdBarrier b; b.bar = bar; b.x = xb_xcc_id(); b.st = st;
    if (threadIdx.x == 0) (void)xb_add(&bar[XB_XCNT(b.x)], 1u);
    return b;
}
__device__ __forceinline__ void xcd_barrier_complete(unsigned* bar, unsigned x, unsigned& nloc, unsigned& nx) {
    const unsigned G = gridDim.x * gridDim.y * gridDim.z;
    unsigned sum, cnt, mine, sp = 0u;
    for (;;) {
        sum = 0u; cnt = 0u; mine = 0u;
#pragma unroll
        for (unsigned j = 0; j < 16; ++j) { const unsigned c = xb_ld(&bar[XB_XCNT(j)]); sum += c; cnt += (c > 0u) ? 1u : 0u; mine = (j == x) ? c : mine; }
        if (sum == G) break;
        __builtin_amdgcn_s_sleep(1);
        if ((++sp & 255u) == 0u) { if (xb_ld(&bar[XB_TMO])) break; if (sp > XB_SPIN_CAP) { atomicAdd(&bar[XB_TMO], 1u); break; } }
    }
    nloc = mine > 0u ? mine : 1u; nx = cnt > 0u ? cnt : 1u;
}
__device__ __forceinline__ void xcd_barrier(const XcdBarrier& b) {
    asm volatile("s_waitcnt vmcnt(0)" ::: "memory");
    __syncthreads();
    if (threadIdx.x == 0) {
        unsigned* bar = b.bar;
        __builtin_amdgcn_s_waitcnt(0);
        unsigned nloc = b.st[0], nx = b.st[1];
        if (nloc == 0u) { xcd_barrier_complete(bar, b.x, nloc, nx); b.st[0] = nloc; b.st[1] = nx; }
        const unsigned old = xb_add(&bar[XB_XSUB(b.x)], 1u);
        const unsigned gen = old / nloc;
        if (old + 1u == (gen + 1u) * nloc) {
            __builtin_amdgcn_fence(__ATOMIC_RELEASE, "agent");
            asm volatile("s_waitcnt vmcnt(0)" ::: "memory");
            const unsigned og = xb_add(&bar[XB_TOP], 1u);
            const unsigned tg = og / nx;
            if (og + 1u == (tg + 1u) * nx) xb_add(&bar[XB_TOPGEN], 1u);
            else XB_SPIN(xb_ld(&bar[XB_TOPGEN]) == tg, bar);
            __builtin_amdgcn_fence(__ATOMIC_ACQUIRE, "agent");
            xb_add(&bar[XB_XGEN(b.x)], 1u);
            asm volatile("s_waitcnt vmcnt(0)" ::: "memory");
        } else {
            XB_SPIN(xb_ld(&bar[XB_XGEN(b.x)]) == gen, bar);
            __builtin_amdgcn_fence(__ATOMIC_ACQUIRE, "agent");
            asm volatile("s_waitcnt vmcnt(0)" ::: "memory");
        }
    }
    __syncthreads();
}
#endif

struct Ctx {
    LAS unsigned char* lds; int G, bid;
    const float *x_prompt, *x_sample, *mem_prompt, *state_hgrn, *cache_pool, *cache_swa_k, *cache_swa_v, *state_conv, *cache_mem_k, *cache_mem_v;
    const float *norm1_g, *w_in, *hgrn_lb, *hgrn_norm_g, *pool_w, *pool_scale, *swa_qnorm_g, *swa_knorm_g, *swa_sinks, *mem_norm_g, *w_mem_kv, *mem_qnorm_g, *mem_knorm_g,
        *w_branch, *w_o, *norm2_g, *w_up, *conv_w, *conv_b, *w_down;
    float* out; unsigned char* ws;
};
#define WSP(T, off) ((T*)(c.ws + (off)))
#define PHASE_IDS() int ptid = threadIdx.x; OPQ_V(ptid); const int plane = ptid & 63, pwave = __builtin_amdgcn_readfirstlane(ptid >> 6); (void)plane; (void)pwave

__device__ __forceinline__ void transpose_item(const float* W, int ldw, int K, int N, bf16* WT, LAS float* scr, int item, int lane) {
    const int nblk = N / 32, kb = item / nblk, nb = item % nblk, k0 = 64 * kb, n0 = 32 * nb;
#pragma unroll 8
    for (int i = 0; i < 32; ++i) { const int kk = 2 * i + (lane >> 5); scr[kk * 33 + (lane & 31)] = W[(size_t)(k0 + kk) * ldw + n0 + (lane & 31)]; }
    WAVE_LDS_FENCE();
    const int cc = lane & 7;
#pragma unroll
    for (int j = 0; j < 4; ++j) { const int n = (lane >> 3) + 8 * j; const LAS float* s = scr + (8 * cc) * 33 + n;
        v4u o; o.x = pk2(s[0 * 33], s[1 * 33]); o.y = pk2(s[2 * 33], s[3 * 33]); o.z = pk2(s[4 * 33], s[5 * 33]); o.w = pk2(s[6 * 33], s[7 * 33]);
        *(v4u*)(WT + (size_t)(n0 + n) * K + k0 + 8 * cc) = o; }
    WAVE_LDS_FENCE();
}
__device__ __forceinline__ void rms_row(const float* xrow, const float* g, bf16* orow, int lane) {
    const f32x4* xr = (const f32x4*)xrow + lane; const f32x4* gr = (const f32x4*)g + lane;
    f32x4 v[8]; float s = 0.f;
#pragma unroll
    for (int j = 0; j < 8; ++j) { v[j] = xr[64 * j]; s += (v[j].x * v[j].x + v[j].y * v[j].y) + (v[j].z * v[j].z + v[j].w * v[j].w); }
    const float rstd = 1.0f / sqrtf(wave_sum(s) * (1.f / DM) + EPS);
    v2u* o8 = (v2u*)orow + lane;
#pragma unroll
    for (int j = 0; j < 8; ++j) { const f32x4 gg = gr[64 * j]; v2u w; w.x = pk2(v[j].x * rstd * gg.x, v[j].y * rstd * gg.y); w.y = pk2(v[j].z * rstd * gg.z, v[j].w * rstd * gg.w); o8[64 * j] = w; }
}
__device__ __forceinline__ const float* xrow_in(const Ctx& c, int r) { return r < SEQ ? c.x_prompt + (size_t)r * DM : c.x_sample + (size_t)(r - SEQ) * DM; }

__device__ __forceinline__ void phase_prologue(const Ctx& c) {
    PHASE_IDS();
    LAS float* scr = (LAS float*)(c.lds + pwave * 16384);
    const int gw = c.bid * NWAVES + pwave, NGW = c.G * NWAVES;
    struct Mat { const float* W; int ldw, K, N; bf16* WT; };
    for (int l = 0; l < DEPTH; ++l) {
        for (int mi = 0; mi < 13; ++mi) {
            Mat mt;
            if (mi == 0) mt = Mat{c.w_in + (size_t)l * DM * INC, INC, DM, INC, l == 0 ? WSP(bf16, WS_WIN) : WSP(bf16, WS_WIN1)};
            else if (mi == 1) mt = Mat{c.w_mem_kv + (size_t)l * DM * 2048, 2048, DM, 2048, WSP(bf16, WS_WIN) + (size_t)(INC + 2048 * l) * DM};
            else if (mi < 6) { const int n = mi - 2; mt = Mat{c.w_branch + ((size_t)l * 4 + n) * 1024 * DM, DM, 1024, DM, WSP(bf16, WS_WBR) + ((size_t)l * 4 + n) * 2048 * 1024}; }
            else if (mi == 6) mt = Mat{c.w_o + (size_t)l * DM * DM, DM, DM, DM, WSP(bf16, WS_WO) + (size_t)l * DM * DM};
            else if (mi == 7) mt = Mat{c.w_up + (size_t)l * DM * 2 * DFF, 2 * DFF, DM, 2 * DFF, WSP(bf16, WS_WUP) + (size_t)l * 2 * DFF * DM};
            else if (mi == 8) mt = Mat{c.w_down + (size_t)l * DFF * DM, DM, DFF, DM, WSP(bf16, WS_WDN) + (size_t)l * DM * DFF};
            else { const int g = mi - 9; mt = Mat{c.pool_w + ((size_t)l * 4 + g) * 65536, 256, 256, 256, WSP(bf16, WS_WPL) + ((size_t)l * 4 + g) * 65536}; }
            const int nitems = (mt.K / 64) * (mt.N / 32);
            for (int it = gw; it < nitems; it += NGW) transpose_item(mt.W, mt.ldw, mt.K, mt.N, mt.WT, scr, it, plane);
        }
    }
    float* tab = WSP(float, WS_TAB);
    const int gt = c.bid * NT + ptid, NGT = c.G * NT;
    for (int i = gt; i < 2048; i += NGT) { const int col = i & 1023; float v = 0.f; if (i >= 1024) { const float a0 = c.hgrn_lb[col], a1 = c.hgrn_lb[1024 + col]; v = 1.0f / (1.0f + expf(a0 - a1)); } tab[T_LB + i] = v; }
    for (int i = gt; i < (SEQ + 4) * 8; i += NGT) { const int p = i >> 3, k = i & 7; const float inv = powf(500000.0f, -(float)(2 * k) / 16.0f); const float pos = (p < SEQ) ? (float)p : (float)(PAST_LEN + (p - SEQ));
        const float ang = pos * inv; const float cs = (float)cos((double)ang), sn = (float)sin((double)ang);
        if (p < SEQ) { tab[T_COSP + i] = cs; tab[T_SINP + i] = sn; } else { tab[T_COSS + (i - SEQ * 8)] = cs; tab[T_SINS + (i - SEQ * 8)] = sn; } }
    bf16* XN = WSP(bf16, WS_XN);
    for (int r = gw; r < M + 512; r += NGW) {
        if (r < M) rms_row(xrow_in(c, r), c.norm1_g, XN + (size_t)r * DM, plane);
        else { const int l = (r - M) >> 8, s = (r - M) & 255; rms_row(c.mem_prompt + (size_t)s * DM, c.mem_norm_g + (size_t)l * DM, XN + (size_t)r * DM, plane); }
    }
}

__device__ __forceinline__ void phase_rmsnorm(const Ctx& c, const float* g) {
    PHASE_IDS();
    bf16* XN = WSP(bf16, WS_XN); const int gw = c.bid * NWAVES + pwave, NGW = c.G * NWAVES;
    for (int r = gw; r < M; r += NGW) rms_row(c.out + O_Y + (size_t)r * DM, g, XN + (size_t)r * DM, plane);
}

__device__ __forceinline__ void mix_prep(const Ctx& c, int l) {
    PHASE_IDS();
    bf16* P = WSP(bf16, WS_P); const float* tab = WSP(float, WS_TAB);
    const int gw = c.bid * NWAVES + pwave, NGW = c.G * NWAVES, lane = plane, sub = lane & 7, grp = lane >> 3;
    const float* qg = c.swa_qnorm_g + l * 64; const float* kg = c.swa_knorm_g + l * 64; const float* mg = c.mem_qnorm_g + l * 256;
    for (int r = gw; r < M; r += NGW) {
        const float* cs = (r < SEQ) ? tab + T_COSP + (size_t)r * 8 : tab + T_COSS + ((r - SEQ) & 3) * 8;
        const float* sn = (r < SEQ) ? tab + T_SINP + (size_t)r * 8 : tab + T_SINS + ((r - SEQ) & 3) * 8;
#pragma unroll 1
        for (int pass = 0; pass < 3; ++pass) {
            const int hd = pass * 8 + grp;
            bf16* p = P + (size_t)r * INC + C_QC + hd * 64 + sub * 8;
            float f[8]; unpack8(*(const v4u*)p, f);
            {
                const bool nrm = hd < 20;
                float ss = 0.f;
#pragma unroll
                for (int j = 0; j < 8; ++j) ss += f[j] * f[j];
                ss += __shfl_xor(ss, 1); ss += __shfl_xor(ss, 2); ss += __shfl_xor(ss, 4);
                const float rstd = 1.0f / sqrtf(ss * (1.f / 64.f) + EPS); const float* g = (hd < 16) ? qg : kg;
                if (nrm) {
#pragma unroll
                    for (int j = 0; j < 8; ++j) f[j] = f[j] * rstd * g[sub * 8 + j]; }
                float o[8];
#pragma unroll
                for (int j = 0; j < 8; ++j) o[j] = __shfl_xor(f[j], 1);
                if (nrm && sub == 0) {
#pragma unroll
                    for (int j = 0; j < 8; ++j) f[j] = f[j] * cs[j] - o[j] * sn[j]; }
                else if (nrm && sub == 1) {
#pragma unroll
                    for (int j = 0; j < 8; ++j) f[j] = f[j] * cs[j] + o[j] * sn[j]; }
                if (hd < 16) {
#pragma unroll
                    for (int j = 0; j < 8; ++j) f[j] *= 0.125f; }
                if (nrm) *(v4u*)p = pack8(f);
            }
            if (hd >= 16) {
                const int kh = (hd - 16) & 3; const size_t ob = (hd < 20) ? O_KP : O_VP, os = (hd < 20) ? O_KS : O_VS;
                float* dst = nullptr;
                if (r < SEQ) { if (r >= SEQ - 128) dst = c.out + ob + ((size_t)l * 128 + (r - (SEQ - 128))) * 256 + kh * 64 + sub * 8; }
                else { const int b = (r - SEQ) >> 2, i = (r - SEQ) & 3; dst = c.out + os + (((size_t)l * DECB + b) * 128 + 124 + i) * 256 + kh * 64 + sub * 8; }
                if (dst) { *(f32x4*)dst = (f32x4){f[0], f[1], f[2], f[3]}; *(f32x4*)(dst + 4) = (f32x4){f[4], f[5], f[6], f[7]}; }
            }
        }
        { const int hm = lane >> 4, s16 = lane & 15; bf16* p = P + (size_t)r * INC + C_QM + hm * 256 + s16 * 8; float a[8], b[8]; unpack8(*(const v4u*)p, a); unpack8(*(const v4u*)(p + 128), b);
            float ss = 0.f;
#pragma unroll
            for (int j = 0; j < 8; ++j) ss += a[j] * a[j] + b[j] * b[j];
            ss += __shfl_xor(ss, 1); ss += __shfl_xor(ss, 2); ss += __shfl_xor(ss, 4); ss += __shfl_xor(ss, 8);
            const float rstd = 0.0625f / sqrtf(ss * (1.f / 256.f) + EPS);
#pragma unroll
            for (int j = 0; j < 8; ++j) { a[j] *= rstd * mg[s16 * 8 + j]; b[j] *= rstd * mg[128 + s16 * 8 + j]; }
            *(v4u*)p = pack8(a); *(v4u*)(p + 128) = pack8(b); }
    }
}
__device__ __forceinline__ void mix_memkv(const Ctx& c) {
    PHASE_IDS();
    const float* KV = WSP(float, WS_KVRAW); bf16* KM = WSP(bf16, WS_KMEM); bf16* VT = WSP(bf16, WS_VMEMT);
    const int gw = c.bid * NWAVES + pwave, NGW = c.G * NWAVES, lane = plane;
    for (int it = gw; it < 2 * 256 * 4; it += NGW) {
        const int l = it >> 10, s = (it >> 2) & 255, hm = it & 3;
        const float* kr = KV + (size_t)s * 4096 + l * 2048 + hm * 256; const float* vr = kr + 1024;
        const f32x4 k4 = *(const f32x4*)(kr + lane * 4), v4 = *(const f32x4*)(vr + lane * 4);
        const float ss = wave_sum((k4.x * k4.x + k4.y * k4.y) + (k4.z * k4.z + k4.w * k4.w)); const float rstd = 1.0f / sqrtf(ss * (1.f / 256.f) + EPS);
        const f32x4 g4 = *(const f32x4*)(c.mem_knorm_g + l * 256 + lane * 4); const f32x4 kn = k4 * rstd * g4;
        *(f32x4*)(c.out + O_MKP + ((size_t)l * 256 + s) * 1024 + hm * 256 + lane * 4) = kn;
        *(f32x4*)(c.out + O_MVP + ((size_t)l * 256 + s) * 1024 + hm * 256 + lane * 4) = v4;
        v2u w; w.x = pk2(kn.x, kn.y); w.y = pk2(kn.z, kn.w); *(v2u*)(KM + (((size_t)l * 4 + hm) * 256 + s) * 256 + lane * 4) = w;
        bf16* vt = VT + (((size_t)l * 4 + hm) * 256 + lane * 4) * 256 + s;
        vt[0] = (bf16)f2bf(v4.x); vt[256] = (bf16)f2bf(v4.y); vt[512] = (bf16)f2bf(v4.z); vt[768] = (bf16)f2bf(v4.w);
    }
}
__device__ __forceinline__ void mix_pool(const Ctx& c, int l) {
    PHASE_IDS();
    const bf16* P = WSP(bf16, WS_P); bf16* D = WSP(bf16, WS_D);
    const int gt = c.bid * NT + ptid, NGT = c.G * NT;
    for (int it = gt; it < M * 128; it += NGT) {
        const int r = it >> 7, c8 = (it & 127) * 8, win = 2 << (c8 >> 8);
        float u[8], s[8]; unpack8(*(const v4u*)(P + (size_t)r * INC + C_UB + c8), u);
#pragma unroll
        for (int j = 0; j < 8; ++j) s[j] = u[j];
        float cnt;
        if (r < SEQ) { const int kmax = (r < win - 1) ? r : win - 1; cnt = (float)(kmax + 1);
            for (int k = 1; k <= kmax; ++k) { float t[8]; unpack8(*(const v4u*)(P + (size_t)(r - k) * INC + C_UB + c8), t);
#pragma unroll
                for (int j = 0; j < 8; ++j) s[j] += t[j]; } }
        else { const int b = (r - SEQ) >> 2, i = (r - SEQ) & 3; cnt = (float)win;
            for (int k = 1; k < win; ++k) { const int e = 15 + i - k; float t[8];
                if (e >= 15) unpack8(*(const v4u*)(P + (size_t)(r - k) * INC + C_UB + c8), t);
                else { const float* cp = c.cache_pool + (((size_t)l * DECB + b) * 15 + e) * 1024 + c8; const f32x4 a = *(const f32x4*)cp, bb = *(const f32x4*)(cp + 4); t[0] = a.x; t[1] = a.y; t[2] = a.z; t[3] = a.w; t[4] = bb.x; t[5] = bb.y; t[6] = bb.z; t[7] = bb.w; }
#pragma unroll
                for (int j = 0; j < 8; ++j) s[j] += t[j]; } }
        const float ic = 1.0f / cnt; float d[8];
#pragma unroll
        for (int j = 0; j < 8; ++j) d[j] = s[j] * ic - u[j];
        *(v4u*)(D + (size_t)r * 1024 + c8) = pack8(d);
        if (r < SEQ) { if (r >= SEQ - 15) { float* o = c.out + O_PLP + ((size_t)l * 15 + (r - (SEQ - 15))) * 1024 + c8; *(f32x4*)o = (f32x4){u[0], u[1], u[2], u[3]}; *(f32x4*)(o + 4) = (f32x4){u[4], u[5], u[6], u[7]}; } }
        else { const int b = (r - SEQ) >> 2, i = (r - SEQ) & 3; float* ob = c.out + O_PLS + ((size_t)l * DECB + b) * 15 * 1024 + c8;
            *(f32x4*)(ob + (size_t)(11 + i) * 1024) = (f32x4){u[0], u[1], u[2], u[3]}; *(f32x4*)(ob + (size_t)(11 + i) * 1024 + 4) = (f32x4){u[4], u[5], u[6], u[7]};
            for (int j = i; j < 11; j += 4) { const float* cp = c.cache_pool + (((size_t)l * DECB + b) * 15 + j + 4) * 1024 + c8; *(f32x4*)(ob + (size_t)j * 1024) = *(const f32x4*)cp; *(f32x4*)(ob + (size_t)j * 1024 + 4) = *(const f32x4*)(cp + 4); } }
    }
}
#define MFMA16(a, b, cc) __builtin_amdgcn_mfma_f32_16x16x32_bf16((a), (b), (cc), 0, 0, 0)
__device__ __forceinline__ void mix_hgrn_local(const Ctx& c, int l) {
    PHASE_IDS();
    bf16* P = WSP(bf16, WS_P); const float* LOGF = WSP(float, WS_LOGF); float* OLOC = WSP(float, WS_OLOC); float* U = WSP(float, WS_U); float* DTOT = WSP(float, WS_DTOT);
    LAS bf16* QT = (LAS bf16*)(c.lds); LAS bf16* KT = (LAS bf16*)(c.lds + 8704); LAS bf16* KTT = (LAS bf16*)(c.lds + 17408); LAS bf16* VT = (LAS bf16*)(c.lds + 27648);
    LAS bf16* SLT = (LAS bf16*)(c.lds + 37888); LAS float* EBL = (LAS float*)(c.lds + 72704); LAS float* PART = (LAS float*)(c.lds + 73216);
    const int tid = ptid, lane = plane, w = pwave, d = tid & 127, tq = tid >> 7, lr = lane & 15, g = lane >> 4;
    for (int unit = c.bid; unit < 8 * NSC; unit += c.G) {
        const int h = unit & 7, sc = unit >> 3, T0 = sc * 128;
        f32x4 Sl[8];
#pragma unroll
        for (int db = 0; db < 8; ++db) { Sl[db] = (f32x4){0.f, 0.f, 0.f, 0.f}; *(LAS v2u*)(SLT + (16 * w + lr) * 136 + 16 * db + 4 * g) = (v2u){0u, 0u}; }
        float Bprev = 0.f;
#pragma unroll 1
        for (int ch = 0; ch < 4; ++ch) {
            const int t0 = T0 + 32 * ch + 8 * tq;
            float lf[8], pb[8]; float run = 0.f;
#pragma unroll
            for (int j = 0; j < 8; ++j) { lf[j] = LOGF[(size_t)(t0 + j) * 1024 + h * 128 + d]; run += lf[j]; pb[j] = run; }
            PART[tq * 128 + d] = run;
            __syncthreads();
            float off = 0.f, bl = 0.f;
#pragma unroll
            for (int q = 0; q < 4; ++q) { const float pq = PART[q * 128 + d]; if (q < tq) off += pq; bl += pq; }
            unsigned ktp[4], vtp[4];
#pragma unroll
            for (int j = 0; j < 8; ++j) {
                const float b = off + pb[j]; bf16* qp = P + (size_t)(t0 + j) * INC + C_QA + h * 128 + d;
                const float q = bf2f(*qp); const unsigned vb = *(const bf16*)(P + (size_t)(t0 + j) * INC + C_IA + h * 128 + d);
                const float eb = __expf(b), einv = __expf(fminf(-b, 80.f)), kk = 1.0f - __expf(lf[j]);
                const float qt = q * eb, kt = kk * einv; const unsigned qtb = f2bf(qt), ktb = f2bf(kt);
                QT[(8 * tq + j) * 136 + d] = (bf16)qtb; KT[(8 * tq + j) * 136 + d] = (bf16)ktb;
                if (j & 1) { ktp[j >> 1] |= ktb << 16; vtp[j >> 1] |= vb << 16; } else { ktp[j >> 1] = ktb; vtp[j >> 1] = vb; }
                *qp = (bf16)f2bf(qt * __expf(Bprev));
            }
            *(LAS v4u*)(KTT + d * 40 + 8 * tq) = (v4u){ktp[0], ktp[1], ktp[2], ktp[3]};
            *(LAS v4u*)(VT + d * 40 + 8 * tq) = (v4u){vtp[0], vtp[1], vtp[2], vtp[3]};
            if (tq == 0) EBL[d] = __expf(bl);
            Bprev += bl;
            __syncthreads();
            bf16x8 qf[2][4];
#pragma unroll
            for (int tb = 0; tb < 2; ++tb)
#pragma unroll
                for (int ks = 0; ks < 4; ++ks) qf[tb][ks] = *(const LAS bf16x8*)(QT + (16 * tb + lr) * 136 + 32 * ks + 8 * g);
            f32x4 st[2][2];
#pragma unroll
            for (int sb = 0; sb < 2; ++sb)
#pragma unroll
                for (int tb = 0; tb < 2; ++tb) { f32x4 a = (f32x4){0.f, 0.f, 0.f, 0.f};
#pragma unroll
                    for (int ks = 0; ks < 4; ++ks) a = MFMA16(*(const LAS bf16x8*)(KT + (16 * sb + lr) * 136 + 32 * ks + 8 * g), qf[tb][ks], a);
#pragma unroll
                    for (int j = 0; j < 4; ++j) if (16 * sb + 4 * g + j > 16 * tb + lr) a[j] = 0.f;
                    st[sb][tb] = a; }
            const v2u vlo = *(const LAS v2u*)(VT + (16 * w + lr) * 40 + 4 * g), vhi = *(const LAS v2u*)(VT + (16 * w + lr) * 40 + 16 + 4 * g);
            const bf16x8 vperm = __builtin_bit_cast(bf16x8, (v4u){vlo.x, vlo.y, vhi.x, vhi.y});
#pragma unroll
            for (int tb = 0; tb < 2; ++tb) {
                f32x4 o = (f32x4){0.f, 0.f, 0.f, 0.f};
#pragma unroll
                for (int ks = 0; ks < 4; ++ks) o = MFMA16(*(const LAS bf16x8*)(SLT + (16 * w + lr) * 136 + 32 * ks + 8 * g), qf[tb][ks], o);
                const bf16x8 pf = __builtin_bit_cast(bf16x8, (v4u){pk2(st[0][tb][0], st[0][tb][1]), pk2(st[0][tb][2], st[0][tb][3]), pk2(st[1][tb][0], st[1][tb][1]), pk2(st[1][tb][2], st[1][tb][3])});
                o = MFMA16(vperm, pf, o);
                *(f32x4*)(OLOC + (size_t)(T0 + 32 * ch + 16 * tb + lr) * 1024 + h * 128 + 16 * w + 4 * g) = o;
            }
            const bf16x8 vnat = *(const LAS bf16x8*)(VT + (16 * w + lr) * 40 + 8 * g);
#pragma unroll
            for (int db = 0; db < 8; ++db) {
                Sl[db] = MFMA16(*(const LAS bf16x8*)(KTT + (16 * db + lr) * 40 + 8 * g), vnat, Sl[db]);
                const f32x4 e4 = *(const LAS f32x4*)(EBL + 16 * db + 4 * g); Sl[db] = Sl[db] * e4;
                *(LAS v2u*)(SLT + (16 * w + lr) * 136 + 16 * db + 4 * g) = (v2u){pk2(Sl[db][0], Sl[db][1]), pk2(Sl[db][2], Sl[db][3])};
            }
            __syncthreads();
        }
#pragma unroll
        for (int db = 0; db < 8; ++db) *(f32x4*)(U + ((size_t)(sc * 8 + h) * 16384) + ((w * 8 + db) * 64 + lane) * 4) = Sl[db];
        if (tq == 0) DTOT[(size_t)(sc * 8 + h) * 128 + d] = __expf(Bprev);
    }
}
__device__ __forceinline__ void mix_hgrn_sample(const Ctx& c, int l) {
    PHASE_IDS();
    const bf16* P = WSP(bf16, WS_P); const float* LOGF = WSP(float, WS_LOGF); bf16* Y = WSP(bf16, WS_Y);
    LAS float* QF = (LAS float*)(c.lds); LAS float* FF = QF + 512; LAS float* KF = FF + 512; LAS float* VF = KF + 512; LAS float* RED = VF + 512; LAS float* SS = RED + 4 * 16 * 128;
    const int tid = ptid, dg = tid >> 5, d0 = dg * 8, e0 = (tid & 31) * 4;
    for (int unit = c.bid; unit < DECB * 8; unit += c.G) {
        const int b = unit >> 3, h = unit & 7; const int r0 = SEQ + 4 * b;
        { const int i = tid >> 7, dd = tid & 127; const size_t rb = (size_t)(r0 + i) * INC + h * 128 + dd;
            QF[tid] = bf2f(P[rb + C_QA]); const float f = __expf(LOGF[(size_t)(r0 + i) * 1024 + h * 128 + dd]); FF[tid] = f; KF[tid] = 1.0f - f; VF[tid] = bf2f(P[rb + C_IA]); }
        const float* sp = c.state_hgrn + (((size_t)l * DECB + b) * 8 + h) * 16384; f32x4 S[8];
#pragma unroll
        for (int j = 0; j < 8; ++j) S[j] = *(const f32x4*)(sp + (size_t)(d0 + j) * 128 + e0);
        __syncthreads();
#pragma unroll
        for (int i = 0; i < 4; ++i) { const f32x4 v4 = *(const LAS f32x4*)(VF + i * 128 + e0); f32x4 part = (f32x4){0.f, 0.f, 0.f, 0.f};
#pragma unroll
            for (int j = 0; j < 8; ++j) { const float f = FF[i * 128 + d0 + j], k = KF[i * 128 + d0 + j], q = QF[i * 128 + d0 + j]; S[j] = S[j] * f + v4 * k; part += S[j] * q; }
            *(LAS f32x4*)(RED + (i * 16 + dg) * 128 + e0) = part; }
        float* so = c.out + O_HSS + (((size_t)l * DECB + b) * 8 + h) * 16384;
#pragma unroll
        for (int j = 0; j < 8; ++j) *(f32x4*)(so + (size_t)(d0 + j) * 128 + e0) = S[j];
        __syncthreads();
        { const int i = tid >> 7, e = tid & 127; float o = 0.f;
#pragma unroll
            for (int q = 0; q < 16; ++q) o += RED[(i * 16 + q) * 128 + e];
            const float ss = wave_sum(o * o); if (plane == 0) SS[pwave] = ss;
            __syncthreads();
            const float tot = SS[2 * i] + SS[2 * i + 1]; const float rstd = 1.0f / sqrtf(tot * (1.f / 128.f) + EPS);
            const float ga = bf2f(P[(size_t)(r0 + i) * INC + C_GA + h * 128 + e]);
            Y[(size_t)(r0 + i) * 4096 + h * 128 + e] = (bf16)f2bf(o * rstd * c.hgrn_norm_g[l * 1024 + h * 128 + e] * ga); }
        __syncthreads();
    }
}

__device__ __forceinline__ void mix_hgrn_scan(const Ctx& c, int l) {
    PHASE_IDS();
    const float* U = WSP(float, WS_U); const float* DTOT = WSP(float, WS_DTOT); bf16* SIN = WSP(bf16, WS_SIN);
    const int gt = c.bid * NT + ptid, NGT = c.G * NT;
    for (int it = gt; it < 8 * 4096; it += NGT) {
        const int h = it >> 12, q4 = it & 4095, ln = q4 & 63, db = (q4 >> 6) & 7, w = q4 >> 9, dd = 16 * db + 4 * (ln >> 4), e = 16 * w + (ln & 15);
        f32x4 S = (f32x4){0.f, 0.f, 0.f, 0.f};
        for (int sc = 0; sc < NSC; ++sc) {
            *(v2u*)(SIN + ((size_t)(sc * 8 + h) * 16384) + q4 * 4) = (v2u){pk2(S[0], S[1]), pk2(S[2], S[3])};
            const f32x4 u4 = *(const f32x4*)(U + ((size_t)(sc * 8 + h) * 16384) + q4 * 4), d4 = *(const f32x4*)(DTOT + (size_t)(sc * 8 + h) * 128 + dd);
            S = S * d4 + u4; }
        float* so = c.out + O_HSP + ((size_t)l * 8 + h) * 16384;
#pragma unroll
        for (int j = 0; j < 4; ++j) so[(size_t)(dd + j) * 128 + e] = S[j];
    }
}
__device__ __forceinline__ void mix_swa_prompt(const Ctx& c, int l) {
    PHASE_IDS();
    const bf16* P = WSP(bf16, WS_P); bf16* Y = WSP(bf16, WS_Y);
    LAS bf16* KI = (LAS bf16*)(c.lds); LAS bf16* VTI = (LAS bf16*)(c.lds + 192 * 72 * 2);
    const int tid = ptid, lane = plane, w = pwave, lr = lane & 15, g = lane >> 4;
    for (int unit = c.bid; unit < 4 * (SEQ / 64); unit += c.G) {
        const int kh = unit & 3, qb = unit >> 2, s0 = 64 * qb - 128;
        for (int it = tid; it < 192 * 8; it += NT) { const int s = it >> 3, ck = it & 7, sa = s0 + s; v4u kv = (v4u){0u, 0u, 0u, 0u}, vv = kv;
            if (sa >= 0) { kv = *(const v4u*)(P + (size_t)sa * INC + C_KC + kh * 64 + ck * 8); vv = *(const v4u*)(P + (size_t)sa * INC + C_VC + kh * 64 + ck * 8); }
            *(LAS v4u*)(KI + s * 72 + ck * 8) = kv;
            LAS bf16* vt = VTI + (ck * 8) * 200 + s;
            vt[0] = (bf16)(vv.x & 0xffff); vt[200] = (bf16)(vv.x >> 16); vt[400] = (bf16)(vv.y & 0xffff); vt[600] = (bf16)(vv.y >> 16);
            vt[800] = (bf16)(vv.z & 0xffff); vt[1000] = (bf16)(vv.z >> 16); vt[1200] = (bf16)(vv.w & 0xffff); vt[1400] = (bf16)(vv.w >> 16); }
        __syncthreads();
        const int hq = 4 * kh + (w >> 1), tq0 = 64 * qb + 32 * (w & 1);
        bf16x8 qf[2][2];
#pragma unroll
        for (int tb = 0; tb < 2; ++tb)
#pragma unroll
            for (int ks = 0; ks < 2; ++ks) qf[tb][ks] = *(const bf16x8*)(P + (size_t)(tq0 + 16 * tb + lr) * INC + C_QC + hq * 64 + 32 * ks + 8 * g);
        const float sink = c.swa_sinks[l * 16 + hq];
        f32x4 st[2][12];
#pragma unroll
        for (int sb = 0; sb < 12; ++sb) {
            const bf16x8 k0 = *(const LAS bf16x8*)(KI + (16 * sb + lr) * 72 + 8 * g), k1 = *(const LAS bf16x8*)(KI + (16 * sb + lr) * 72 + 32 + 8 * g);
#pragma unroll
            for (int tb = 0; tb < 2; ++tb) { f32x4 a = MFMA16(k0, qf[tb][0], ((f32x4){0.f, 0.f, 0.f, 0.f})); a = MFMA16(k1, qf[tb][1], a); st[tb][sb] = a; } }
        float inv[2];
#pragma unroll
        for (int tb = 0; tb < 2; ++tb) {
            const int ta = tq0 + 16 * tb + lr; float mx = sink;
#pragma unroll
            for (int sb = 0; sb < 12; ++sb)
#pragma unroll
                for (int j = 0; j < 4; ++j) { const int sa = s0 + 16 * sb + 4 * g + j; const bool ok = sa >= 0 && sa <= ta && ta - sa < 128; const float v = ok ? st[tb][sb][j] : -1e30f; st[tb][sb][j] = v; mx = fmaxf(mx, v); }
            mx = fmaxf(mx, __shfl_xor(mx, 16)); mx = fmaxf(mx, __shfl_xor(mx, 32));
            float sum = 0.f;
#pragma unroll
            for (int sb = 0; sb < 12; ++sb)
#pragma unroll
                for (int j = 0; j < 4; ++j) { const float p = __expf(st[tb][sb][j] - mx); st[tb][sb][j] = p; sum += p; }
            sum += __shfl_xor(sum, 16); sum += __shfl_xor(sum, 32);
            inv[tb] = 1.0f / (sum + __expf(sink - mx));
        }
        f32x4 o[2][4];
#pragma unroll
        for (int tb = 0; tb < 2; ++tb)
#pragma unroll
            for (int eb = 0; eb < 4; ++eb) o[tb][eb] = (f32x4){0.f, 0.f, 0.f, 0.f};
#pragma unroll
        for (int kk = 0; kk < 6; ++kk) {
            bf16x8 pf[2];
#pragma unroll
            for (int tb = 0; tb < 2; ++tb) pf[tb] = __builtin_bit_cast(bf16x8, (v4u){pk2(st[tb][2 * kk][0], st[tb][2 * kk][1]), pk2(st[tb][2 * kk][2], st[tb][2 * kk][3]), pk2(st[tb][2 * kk + 1][0], st[tb][2 * kk + 1][1]), pk2(st[tb][2 * kk + 1][2], st[tb][2 * kk + 1][3])});
#pragma unroll
            for (int eb = 0; eb < 4; ++eb) { const v2u vlo = *(const LAS v2u*)(VTI + (16 * eb + lr) * 200 + 32 * kk + 4 * g), vhi = *(const LAS v2u*)(VTI + (16 * eb + lr) * 200 + 32 * kk + 16 + 4 * g);
                const bf16x8 vf = __builtin_bit_cast(bf16x8, (v4u){vlo.x, vlo.y, vhi.x, vhi.y});
#pragma unroll
                for (int tb = 0; tb < 2; ++tb) o[tb][eb] = MFMA16(vf, pf[tb], o[tb][eb]); } }
#pragma unroll
        for (int tb = 0; tb < 2; ++tb)
#pragma unroll
            for (int eb = 0; eb < 4; ++eb) { const f32x4 v = o[tb][eb] * inv[tb]; *(v2u*)(Y + (size_t)(tq0 + 16 * tb + lr) * 4096 + 2048 + hq * 64 + 16 * eb + 4 * g) = (v2u){pk2(v[0], v[1]), pk2(v[2], v[3])}; }
        __syncthreads();
    }
}
__device__ __forceinline__ void mix_swa_sample(const Ctx& c, int l) {
    PHASE_IDS();
    const bf16* P = WSP(bf16, WS_P); bf16* Y = WSP(bf16, WS_Y);
    LAS float* KF = (LAS float*)(c.lds); LAS float* VF = KF + 132 * 65; LAS float* QF = VF + 132 * 64; LAS float* SC = QF + 16 * 64; LAS float* DEN = SC + 16 * 136;
    const int tid = ptid;
    for (int unit = c.bid; unit < DECB * 4; unit += c.G) {
        const int b = unit >> 2, kh = unit & 3, r0 = SEQ + 4 * b;
        const float* kc = c.cache_swa_k + ((size_t)l * DECB + b) * 128 * 256 + kh * 64; const float* vc = c.cache_swa_v + ((size_t)l * DECB + b) * 128 * 256 + kh * 64;
        float* ko = c.out + O_KS + ((size_t)l * DECB + b) * 128 * 256 + kh * 64; float* vo = c.out + O_VS + ((size_t)l * DECB + b) * 128 * 256 + kh * 64;
        for (int it = tid; it < 128 * 16; it += NT) { const int s = it >> 4, q4 = (it & 15) * 4; const f32x4 k4 = *(const f32x4*)(kc + (size_t)s * 256 + q4), v4 = *(const f32x4*)(vc + (size_t)s * 256 + q4);
            KF[s * 65 + q4] = k4.x; KF[s * 65 + q4 + 1] = k4.y; KF[s * 65 + q4 + 2] = k4.z; KF[s * 65 + q4 + 3] = k4.w; *(LAS f32x4*)(VF + s * 64 + q4) = v4;
            if (s >= 4) { *(f32x4*)(ko + (size_t)(s - 4) * 256 + q4) = k4; *(f32x4*)(vo + (size_t)(s - 4) * 256 + q4) = v4; } }
        if (tid < 256) { const int i = tid >> 6, dd = tid & 63; KF[(128 + i) * 65 + dd] = bf2f(P[(size_t)(r0 + i) * INC + C_KC + kh * 64 + dd]); VF[(128 + i) * 64 + dd] = bf2f(P[(size_t)(r0 + i) * INC + C_VC + kh * 64 + dd]); }
        for (int it = tid; it < 16 * 64; it += NT) { const int row = it >> 6, dd = it & 63, i = row >> 2, hl = row & 3; QF[it] = bf2f(P[(size_t)(r0 + i) * INC + C_QC + (4 * kh + hl) * 64 + dd]); }
        __syncthreads();
        { const int row = tid >> 5, ks = tid & 31, i = row >> 2, hl = row & 3; const float sink = c.swa_sinks[l * 16 + 4 * kh + hl]; float mx = sink;
            for (int ci = ks; ci < 132; ci += 32) { float s = 0.f;
#pragma unroll 8
                for (int dd = 0; dd < 64; ++dd) s += QF[row * 64 + dd] * KF[ci * 65 + dd];
                const bool ok = ci > i && ci <= i + 128; s = ok ? s : -1e30f; SC[row * 136 + ci] = s; mx = fmaxf(mx, s); }
#pragma unroll
            for (int o = 1; o < 32; o <<= 1) mx = fmaxf(mx, __shfl_xor(mx, o));
            float sum = 0.f;
            for (int ci = ks; ci < 132; ci += 32) { const float p = __expf(SC[row * 136 + ci] - mx); SC[row * 136 + ci] = p; sum += p; }
#pragma unroll
            for (int o = 1; o < 32; o <<= 1) sum += __shfl_xor(sum, o);
            if (ks == 0) DEN[row] = 1.0f / (sum + __expf(sink - mx)); }
        __syncthreads();
        { const int row = tid >> 5, e = tid & 31, i = row >> 2, hl = row & 3; float o0 = 0.f, o1 = 0.f;
            for (int ci = 0; ci < 132; ++ci) { const float p = SC[row * 136 + ci]; o0 += p * VF[ci * 64 + e]; o1 += p * VF[ci * 64 + 32 + e]; }
            const float inv = DEN[row]; bf16* yp = Y + (size_t)(r0 + i) * 4096 + 2048 + (4 * kh + hl) * 64;
            yp[e] = (bf16)f2bf(o0 * inv); yp[32 + e] = (bf16)f2bf(o1 * inv); }
        __syncthreads();
    }
}
__device__ __forceinline__ void mix_mem_sample(const Ctx& c, int l) {
    PHASE_IDS();
    const bf16* P = WSP(bf16, WS_P); bf16* Y = WSP(bf16, WS_Y);
    LAS float* QF = (LAS float*)(c.lds); LAS float* SC = QF + 1024; LAS float* DEN = SC + 1024; LAS float* PART = DEN + 8;
    const int tid = ptid, lane = plane, w = pwave, g = lane >> 4, l16 = lane & 15;
    for (int unit = c.bid; unit < DECB * 4; unit += c.G) {
        const int b = unit >> 2, hm = unit & 3, r0 = SEQ + 4 * b;
        for (int it = tid; it < 1024; it += NT) QF[it] = bf2f(P[(size_t)(r0 + (it >> 8)) * INC + C_QM + hm * 256 + (it & 255)]);
        __syncthreads();
        const float* kb = c.cache_mem_k + ((size_t)l * DECB + b) * 256 * 1024 + hm * 256; const float* vb = c.cache_mem_v + ((size_t)l * DECB + b) * 256 * 1024 + hm * 256;
        f32x4 q4[4][4];
#pragma unroll
        for (int i = 0; i < 4; ++i)
#pragma unroll
            for (int cc = 0; cc < 4; ++cc) q4[i][cc] = *(const LAS f32x4*)(QF + i * 256 + 64 * cc + 4 * l16);
#pragma unroll 2
        for (int it = 0; it < 8; ++it) { const int s = 32 * w + 4 * it + g; const float* kr = kb + (size_t)s * 1024 + 4 * l16; f32x4 k4[4];
#pragma unroll
            for (int cc = 0; cc < 4; ++cc) k4[cc] = *(const f32x4*)(kr + 64 * cc);
            float d[4];
#pragma unroll
            for (int i = 0; i < 4; ++i) { f32x4 a = q4[i][0] * k4[0] + q4[i][1] * k4[1] + q4[i][2] * k4[2] + q4[i][3] * k4[3]; d[i] = (a.x + a.y) + (a.z + a.w); }
#pragma unroll
            for (int o = 1; o < 16; o <<= 1) {
#pragma unroll
                for (int i = 0; i < 4; ++i) d[i] += __shfl_xor(d[i], o); }
            if (l16 < 4) SC[l16 * 256 + s] = (l16 == 0) ? d[0] : (l16 == 1) ? d[1] : (l16 == 2) ? d[2] : d[3]; }
        __syncthreads();
        if (w < 4) { const f32x4 s4 = *(const LAS f32x4*)(SC + w * 256 + 4 * lane); float mx = fmaxf(fmaxf(s4.x, s4.y), fmaxf(s4.z, s4.w));
#pragma unroll
            for (int o = 1; o < 64; o <<= 1) mx = fmaxf(mx, __shfl_xor(mx, o));
            f32x4 p4; p4.x = __expf(s4.x - mx); p4.y = __expf(s4.y - mx); p4.z = __expf(s4.z - mx); p4.w = __expf(s4.w - mx);
            const float sum = wave_sum((p4.x + p4.y) + (p4.z + p4.w)); *(LAS f32x4*)(SC + w * 256 + 4 * lane) = p4; if (lane == 0) DEN[w] = 1.0f / sum; }
        __syncthreads();
        f32x4 acc[4];
#pragma unroll
        for (int i = 0; i < 4; ++i) acc[i] = (f32x4){0.f, 0.f, 0.f, 0.f};
#pragma unroll 8
        for (int it = 0; it < 32; ++it) { const int s = 32 * w + it; const f32x4 v4 = *(const f32x4*)(vb + (size_t)s * 1024 + 4 * lane);
#pragma unroll
            for (int i = 0; i < 4; ++i) acc[i] += v4 * SC[i * 256 + s]; }
#pragma unroll
        for (int i = 0; i < 4; ++i) *(LAS f32x4*)(PART + (w * 4 + i) * 256 + 4 * lane) = acc[i];
        __syncthreads();
        for (int it = tid; it < 1024; it += NT) { const int i = it >> 8, e = it & 255; float o = 0.f;
#pragma unroll
            for (int q = 0; q < 8; ++q) o += PART[(q * 4 + i) * 256 + e];
            Y[(size_t)(r0 + i) * 4096 + 3072 + hm * 256 + e] = (bf16)f2bf(o * DEN[i]); }
        __syncthreads();
    }
}

__device__ __forceinline__ void mix_hgrn_final(const Ctx& c, int l) {
    PHASE_IDS();
    const bf16* P = WSP(bf16, WS_P); const float* OLOC = WSP(float, WS_OLOC); const bf16* SIN = WSP(bf16, WS_SIN); bf16* Y = WSP(bf16, WS_Y);
    LAS bf16* SI = (LAS bf16*)(c.lds);
    const int tid = ptid, lane = plane, w = pwave, lr = lane & 15, g = lane >> 4;
    for (int unit = c.bid; unit < 8 * NSC; unit += c.G) {
        const int h = unit & 7, sc = unit >> 3, t = sc * 128 + 16 * w + lr;
        for (int it = tid; it < 2048; it += NT) *(LAS v4u*)(SI + it * 8) = *(const v4u*)(SIN + (size_t)(sc * 8 + h) * 16384 + it * 8);
        __syncthreads();
        bf16x8 qf[4];
#pragma unroll
        for (int ks = 0; ks < 4; ++ks) qf[ks] = *(const bf16x8*)(P + (size_t)t * INC + C_QA + h * 128 + 32 * ks + 8 * g);
        f32x4 o[8]; float ss = 0.f;
#pragma unroll
        for (int eb = 0; eb < 8; ++eb) { f32x4 a = *(const f32x4*)(OLOC + (size_t)t * 1024 + h * 128 + 16 * eb + 4 * g);
#pragma unroll
            for (int ks = 0; ks < 4; ++ks) { const int idx = ((eb * 8 + 2 * ks + (g >> 1)) * 64 + (2 * (g & 1)) * 16 + lr) * 4;
                const v2u lo = *(const LAS v2u*)(SI + idx), hi = *(const LAS v2u*)(SI + idx + 64);
                a = MFMA16(__builtin_bit_cast(bf16x8, (v4u){lo.x, lo.y, hi.x, hi.y}), qf[ks], a); }
            o[eb] = a; ss += (a[0] * a[0] + a[1] * a[1]) + (a[2] * a[2] + a[3] * a[3]); }
        ss += __shfl_xor(ss, 16); ss += __shfl_xor(ss, 32);
        const float rstd = 1.0f / sqrtf(ss * (1.f / 128.f) + EPS);
#pragma unroll
        for (int eb = 0; eb < 8; ++eb) { const int e = h * 128 + 16 * eb + 4 * g; const f32x4 g4 = *(const f32x4*)(c.hgrn_norm_g + l * 1024 + e); const v2u gw = *(const v2u*)(P + (size_t)t * INC + C_GA + e);
            const f32x4 v = o[eb] * rstd * g4; *(v2u*)(Y + (size_t)t * 4096 + e) = (v2u){pk2(v[0] * bflo(gw.x), v[1] * bfhi(gw.x)), pk2(v[2] * bflo(gw.y), v[3] * bfhi(gw.y))}; }
        __syncthreads();
    }
}

__device__ __forceinline__ void phase_convact(const Ctx& c, int l) {
    PHASE_IDS();
    const bf16* AV = WSP(bf16, WS_P); bf16* ACT = WSP(bf16, WS_ACT);
    const float* cw = c.conv_w + (size_t)l * 3 * DFF; const float* cb = c.conv_b + (size_t)l * DFF;
    const int gt = c.bid * NT + ptid, NGT = c.G * NT;
    for (int it = gt; it < M * (DFF / 8); it += NGT) {
        const int r = it / (DFF / 8), c8 = (it % (DFF / 8)) * 8;
        float a0[8], a1[8], a2[8], v[8]; unpack8(*(const v4u*)(AV + (size_t)r * 2 * DFF + c8), a2); unpack8(*(const v4u*)(AV + (size_t)r * 2 * DFF + DFF + c8), v);
        int i = r, b = 0; if (r >= SEQ) { i = (r - SEQ) & 3; b = (r - SEQ) >> 2; }
        if (i >= 1) unpack8(*(const v4u*)(AV + (size_t)(r - 1) * 2 * DFF + c8), a1);
        else if (r >= SEQ) { const float* sp = c.state_conv + (((size_t)l * DECB + b) * 2 + 1) * DFF + c8;
#pragma unroll
            for (int j = 0; j < 8; ++j) a1[j] = sp[j]; }
        else {
#pragma unroll
            for (int j = 0; j < 8; ++j) a1[j] = 0.f; }
        if (i >= 2) unpack8(*(const v4u*)(AV + (size_t)(r - 2) * 2 * DFF + c8), a0);
        else if (r >= SEQ) { const float* sp = c.state_conv + (((size_t)l * DECB + b) * 2 + i) * DFF + c8;
#pragma unroll
            for (int j = 0; j < 8; ++j) a0[j] = sp[j]; }
        else {
#pragma unroll
            for (int j = 0; j < 8; ++j) a0[j] = 0.f; }
        float o[8];
#pragma unroll
        for (int j = 0; j < 8; ++j) { const float cc = cb[c8 + j] + cw[c8 + j] * a0[j] + cw[DFF + c8 + j] * a1[j] + cw[2 * DFF + c8 + j] * a2[j]; o[j] = gelu_as(cc) * v[j]; }
        *(v4u*)(ACT + (size_t)r * DFF + c8) = pack8(o);
        float* dst = nullptr;
        if (r < SEQ) { if (r >= SEQ - 2) dst = c.out + O_CVP + ((size_t)l * 2 + (r - (SEQ - 2))) * DFF + c8; }
        else if (i >= 2) dst = c.out + O_CVS + (((size_t)l * DECB + b) * 2 + (i - 2)) * DFF + c8;
        if (dst) { *(f32x4*)dst = (f32x4){a2[0], a2[1], a2[2], a2[3]}; *(f32x4*)(dst + 4) = (f32x4){a2[4], a2[5], a2[6], a2[7]}; }
    }
}

constexpr int NPH = 1 + 11 * DEPTH - 1;
constexpr int RING_BYTES = 131072, MISC_OFF = RING_BYTES, LDS_BYTES = 147456;
struct Args { const float* in[30]; float* out; unsigned char* ws; int ph_lo, ph_hi; };
#ifdef EMU
void fwd_kernel(void* vp) { const Args& args = *(const Args*)vp; unsigned char* lds = emu_lds;
#else
__global__ void __launch_bounds__(NT, 2) fwd_kernel(Args args) {
    extern __shared__ __attribute__((aligned(16))) unsigned char lds[];
#endif
    Ctx c;
    c.lds = (LAS unsigned char*)lds; c.G = gridDim.x; c.bid = blockIdx.x;
    c.x_prompt = args.in[0]; c.x_sample = args.in[1]; c.mem_prompt = args.in[2]; c.state_hgrn = args.in[3]; c.cache_pool = args.in[4]; c.cache_swa_k = args.in[5]; c.cache_swa_v = args.in[6];
    c.state_conv = args.in[7]; c.cache_mem_k = args.in[8]; c.cache_mem_v = args.in[9]; c.norm1_g = args.in[10]; c.w_in = args.in[11]; c.hgrn_lb = args.in[12]; c.hgrn_norm_g = args.in[13];
    c.pool_w = args.in[14]; c.pool_scale = args.in[15]; c.swa_qnorm_g = args.in[16]; c.swa_knorm_g = args.in[17]; c.swa_sinks = args.in[18]; c.mem_norm_g = args.in[19]; c.w_mem_kv = args.in[20];
    c.mem_qnorm_g = args.in[21]; c.mem_knorm_g = args.in[22]; c.w_branch = args.in[23]; c.w_o = args.in[24]; c.norm2_g = args.in[25]; c.w_up = args.in[26]; c.conv_w = args.in[27]; c.conv_b = args.in[28]; c.w_down = args.in[29];
    c.out = args.out; c.ws = args.ws;
    const int lo = args.ph_lo, hi = args.ph_hi;
#ifndef EMU
    volatile LAS unsigned* misc = (volatile LAS unsigned*)(c.lds + MISC_OFF);
    if (threadIdx.x < 16) misc[threadIdx.x] = 0u;
    __syncthreads();
    XcdBarrier bar; bar.bar = (unsigned*)(c.ws + WS_CTL) + 1024; bar.x = 0; bar.st = nullptr;
    if (hi - lo > 1) bar = xcd_barrier_post((unsigned*)(c.ws + WS_CTL) + 1024, misc + 8);
#define SEAM(k) do { if (IN(k) && IN((k) + 1)) xcd_barrier(bar); } while (0)
#else
#define SEAM(k) do { } while (0)
#endif
#define IN(k) (lo <= (k) && (k) < hi)
#ifndef PH_MASK
#define PH_MASK 0xfff
#endif
#define EN(kind) (((PH_MASK) >> (kind)) & 1)
#ifndef SUB_MASK
#define SUB_MASK 0xffff
#endif
#define SUB(k) (((SUB_MASK) >> (k)) & 1)
    if (EN(0) && IN(0)) { phase_prologue(c); }
    SEAM(0);
#pragma unroll 1
    for (int l = 0; l < DEPTH; ++l) {
        const int pb = (l == 0) ? 1 : 11;
        if (l > 0) { if (EN(7) && IN(pb)) phase_rmsnorm(c, c.norm1_g + (size_t)l * DM); SEAM(pb); }
        const int p0 = (l == 0) ? 1 : 12;
        if (EN(1) && IN(p0)) {
            pg8::Gemm g{WSP(bf16, WS_XN), l == 0 ? WSP(bf16, WS_WIN) : WSP(bf16, WS_WIN1), DM, DM, DM};
            pg8::SchedIn S{NPAN, INC / 256, c.G, c.bid, l == 0 ? 16 : 0};
            pg8::EpiIn E{WSP(bf16, WS_P), WSP(float, WS_LOGF), WSP(float, WS_TAB) + T_LB + l * 1024, WSP(float, WS_KVRAW)};
            pg8::gemm_phase<pg8::EpiIn, pg8::SchedIn>(c.lds, g, S, E);
        }
        SEAM(p0);
        if (EN(2) && IN(p0 + 1)) { if (SUB(8)) mix_prep(c, l); if (SUB(9)) { if (l == 0) mix_memkv(c); } if (SUB(10)) mix_pool(c, l); if (SUB(11)) mix_hgrn_local(c, l); if (SUB(12)) mix_hgrn_sample(c, l); }
        SEAM(p0 + 1);
        if (EN(3) && IN(p0 + 2)) {
            if (SUB(0)) { pg8::Gemm g{WSP(bf16, WS_P) + C_QM, WSP(bf16, WS_KMEM) + (size_t)l * 1024 * 256, INC, 256, 256};
              pg8::SchedGrid S{NPP, 4, c.G, c.bid, 256}; pg8::EpiMemS E{WSP(bf16, WS_E), WSP(float, WS_ROWSUM) + (size_t)l * SEQ * 4};
              pg8::gemm_phase<pg8::EpiMemS, pg8::SchedGrid>(c.lds, g, S, E); }
            __syncthreads();
            if (SUB(1)) mix_hgrn_scan(c, l); if (SUB(2)) mix_swa_prompt(c, l); if (SUB(3)) mix_swa_sample(c, l); if (SUB(4)) mix_mem_sample(c, l);
        }
        SEAM(p0 + 2);
        if (EN(4) && IN(p0 + 3)) {
            if (SUB(5)) { pg8::Gemm g{WSP(bf16, WS_E), WSP(bf16, WS_VMEMT) + (size_t)l * 1024 * 256, 1024, 256, 256};
              pg8::SchedGrid S{NPP, 4, c.G, c.bid, 256}; pg8::EpiBf16S E{WSP(bf16, WS_Y), 4096, 3072, 256, nullptr, WSP(float, WS_ROWSUM) + (size_t)l * SEQ * 4, 4};
              pg8::gemm_phase<pg8::EpiBf16S, pg8::SchedGrid>(c.lds, g, S, E); }
            __syncthreads();
            if (SUB(6)) { pg8::Gemm g{WSP(bf16, WS_D), WSP(bf16, WS_WPL) + (size_t)l * 1024 * 256, 1024, 256, 256};
              pg8::SchedGrid S{NPAN, 4, c.G, c.bid, 256}; pg8::EpiBf16S E{WSP(bf16, WS_Y), 4096, 1024, 256, c.pool_scale + (size_t)l * 1024, nullptr, 0};
              pg8::gemm_phase<pg8::EpiBf16S, pg8::SchedGrid>(c.lds, g, S, E); }
            __syncthreads();
            if (SUB(7)) mix_hgrn_final(c, l);
        }
        SEAM(p0 + 3);
        if (EN(5) && IN(p0 + 4)) {
            pg8::Gemm g{WSP(bf16, WS_Y), WSP(bf16, WS_WBR) + (size_t)l * 8192 * 1024, 4096, 1024, 1024};
            pg8::SchedBranch S{NPAN, c.G, c.bid}; pg8::EpiBranch E{WSP(bf16, WS_P), WSP(float, WS_MACC), WSP(bf16, WS_MERGED)};
            pg8::gemm_phase<pg8::EpiBranch, pg8::SchedBranch>(c.lds, g, S, E);
        }
        SEAM(p0 + 4);
        if (EN(6) && IN(p0 + 5)) {
            pg8::Gemm g{WSP(bf16, WS_MERGED), WSP(bf16, WS_WO) + (size_t)l * DM * DM, DM, DM, DM};
            pg8::SchedGrid S{NPAN, 8, c.G, c.bid, 0};
            pg8::EpiRes E{l == 0 ? c.x_prompt : c.out + O_Y, l == 0 ? c.x_sample : c.out + O_Y + (size_t)SEQ * DM, c.out + O_Y};
            pg8::gemm_phase<pg8::EpiRes, pg8::SchedGrid>(c.lds, g, S, E);
        }
        SEAM(p0 + 5);
        if (EN(7) && IN(p0 + 6)) phase_rmsnorm(c, c.norm2_g + (size_t)l * DM);
        SEAM(p0 + 6);
        if (EN(8) && IN(p0 + 7)) {
            pg8::Gemm g{WSP(bf16, WS_XN), WSP(bf16, WS_WUP) + (size_t)l * 2 * DFF * DM, DM, DM, DM};
            pg8::SchedGrid S{NPAN, 2 * DFF / 256, c.G, c.bid, 0}; pg8::EpiBf16S E{WSP(bf16, WS_P), 2 * DFF, 0, 256, nullptr, nullptr, 0};
            pg8::gemm_phase<pg8::EpiBf16S, pg8::SchedGrid>(c.lds, g, S, E);
        }
        SEAM(p0 + 7);
        if (EN(9) && IN(p0 + 8)) phase_convact(c, l);
        SEAM(p0 + 8);
        if (EN(10) && IN(p0 + 9)) {
            pg8::Gemm g{WSP(bf16, WS_ACT), WSP(bf16, WS_WDN) + (size_t)l * DM * DFF, DFF, DFF, DFF};
            pg8::SchedGrid S{NPAN, 8, c.G, c.bid, 0}; pg8::EpiRes E{c.out + O_Y, c.out + O_Y + (size_t)SEQ * DM, c.out + O_Y};
            pg8::gemm_phase<pg8::EpiRes, pg8::SchedGrid>(c.lds, g, S, E);
        }
        if (l == 0) SEAM(p0 + 9);
    }
#undef IN
#undef SEAM
}

extern "C" void kernel_launch(void* const* d_in, const int* in_sizes, int n_in, void* d_out, int out_size, void* d_ws, size_t ws_size, hipStream_t stream) {
    if (n_in != 30 || (size_t)out_size != O_END || ws_size < WS_END) { fprintf(stderr, "kernel_launch: shape mismatch: n_in %d out %d (want %zu) ws %zu (want %zu)\n", n_in, out_size, (size_t)O_END, ws_size, (size_t)WS_END); return; }
    Args a{};
    for (int i = 0; i < 30; ++i) a.in[i] = (const float*)d_in[i];
    a.out = (float*)d_out; a.ws = (unsigned char*)d_ws;
    (void)hipMemsetAsync((char*)d_ws + WS_CTL, 0, ZERO_BYTES, stream);
#ifdef EMU
    const char* pe = getenv("EMU_PH_LO"); const char* ph = getenv("EMU_PH_HI"); const int plo = pe ? atoi(pe) : 0, phi = ph ? atoi(ph) : NPH;
    for (int p = plo; p < phi; ++p) { a.ph_lo = p; a.ph_hi = p + 1; fprintf(stderr, "[emu] phase %d\n", p); emu_launch(fwd_kernel, &a, 2, NT, LDS_BYTES); }
#else
    static int grid = 0;
    if (grid == 0) {
        int dev = 0, cus = 0;
        if (hipGetDevice(&dev) != hipSuccess || hipDeviceGetAttribute(&cus, hipDeviceAttributeMultiprocessorCount, dev) != hipSuccess) { grid = -1; return; }
        if (hipFuncSetAttribute((const void*)fwd_kernel, hipFuncAttributeMaxDynamicSharedMemorySize, LDS_BYTES) != hipSuccess) { fprintf(stderr, "kernel_launch: hipFuncSetAttribute failed\n"); grid = -1; return; }
        int per_cu = 0; (void)hipOccupancyMaxActiveBlocksPerMultiprocessor(&per_cu, (const void*)fwd_kernel, NT, LDS_BYTES); (void)hipGetLastError();
        grid = cus;
    }
    if (grid < 0) return;
    if (MK_N_LAUNCHES == 1) { a.ph_lo = 0; a.ph_hi = NPH; hipLaunchKernelGGL(fwd_kernel, dim3(grid), dim3(NT), LDS_BYTES, stream, a); }
    else for (int p = 0; p < NPH; ++p) { a.ph_lo = p; a.ph_hi = p + 1; hipLaunchKernelGGL(fwd_kernel, dim3(grid), dim3(NT), LDS_BYTES, stream, a); }
#endif
}
#ifdef EMU
size_t emu_ws_bytes() { return WS_END; }
size_t emu_out_floats() { return O_END; }
#include "emu_wsmap.h"
#endif
```

```cpp
#ifdef EMU
#include "emu.h"
#else
#include <hip/hip_runtime.h>
#endif
#include <cstdio>
#include <cstdint>

#ifndef CFG_SEQ
#define CFG_SEQ 8192
#endif
#ifndef CFG_DECB
#define CFG_DECB 128
#endif
#ifndef MK_N_LAUNCHES
#define MK_N_LAUNCHES 1
#endif

constexpr int SEQ = CFG_SEQ, DECB = CFG_DECB, NS = DECB * 4, M = SEQ + NS, NPAN = M / 256, NPP = SEQ / 256;
constexpr int DM = 2048, MIXW = 1024, INC = 15872, DFF = 5632, NMEM = 256, DEPTH = 2;
constexpr int C_QA = 0, C_FA = 1024, C_IA = 2048, C_GA = 3072, C_UB = 4096, C_QC = 5120, C_KC = 6144, C_VC = 6400, C_QM = 6656, C_GZ = 7680;
constexpr int SCT = 256, NSC = SEQ / SCT, NCH = SCT / 32;
constexpr int PAST_LEN = 8192;
constexpr float EPS = 1e-6f;
static_assert(SEQ % 256 == 0 && NS % 256 == 0, "row panels");

constexpr size_t O_Y = 0;
constexpr size_t O_HSP = (size_t)M * DM;
constexpr size_t O_HSS = O_HSP + (size_t)DEPTH * 8 * 16384;
constexpr size_t O_PLP = O_HSS + (size_t)DEPTH * DECB * 8 * 16384;
constexpr size_t O_PLS = O_PLP + (size_t)DEPTH * 15 * 1024;
constexpr size_t O_KP = O_PLS + (size_t)DEPTH * DECB * 15 * 1024;
constexpr size_t O_KS = O_KP + (size_t)DEPTH * 128 * 256;
constexpr size_t O_VP = O_KS + (size_t)DEPTH * DECB * 128 * 256;
constexpr size_t O_VS = O_VP + (size_t)DEPTH * 128 * 256;
constexpr size_t O_CVP = O_VS + (size_t)DEPTH * DECB * 128 * 256;
constexpr size_t O_CVS = O_CVP + (size_t)DEPTH * 2 * DFF;
constexpr size_t O_MKP = O_CVS + (size_t)DEPTH * DECB * 2 * DFF;
constexpr size_t O_MVP = O_MKP + (size_t)DEPTH * 256 * 1024;
constexpr size_t O_END = O_MVP + (size_t)DEPTH * 256 * 1024;

constexpr size_t al(size_t x) { return (x + 4095) & ~(size_t)4095; }
constexpr size_t WS_CTL = 0, CTL_BYTES = (size_t)1 << 20;
constexpr size_t WS_ROWSUM = WS_CTL + CTL_BYTES, ROWSUM_BYTES = al((size_t)DEPTH * SEQ * 4 * 4);
constexpr size_t ZERO_BYTES = CTL_BYTES + ROWSUM_BYTES;
constexpr size_t WS_TAB = WS_ROWSUM + ROWSUM_BYTES;
constexpr size_t T_LB = 0, T_COSP = 2048, T_SINP = T_COSP + (size_t)SEQ * 8, T_COSS = T_SINP + (size_t)SEQ * 8, T_SINS = T_COSS + 32, T_END = T_SINS + 32;
constexpr size_t WS_WIN = al(WS_TAB + T_END * 4);
constexpr size_t WIN0_ROWS = INC + 2 * 2048;
constexpr size_t WS_WIN1 = al(WS_WIN + WIN0_ROWS * DM * 2);
constexpr size_t WS_WBR = al(WS_WIN1 + (size_t)INC * DM * 2);
constexpr size_t WS_WO = al(WS_WBR + (size_t)DEPTH * 8192 * 1024 * 2);
constexpr size_t WS_WUP = al(WS_WO + (size_t)DEPTH * DM * DM * 2);
constexpr size_t WS_WDN = al(WS_WUP + (size_t)DEPTH * 2 * DFF * DM * 2);
constexpr size_t WS_WPL = al(WS_WDN + (size_t)DEPTH * DM * DFF * 2);
constexpr size_t WS_XN = al(WS_WPL + (size_t)DEPTH * 1024 * 256 * 2);
constexpr size_t WS_P = al(WS_XN + (size_t)(M + 512) * DM * 2);
constexpr size_t WS_LOGF = al(WS_P + (size_t)M * INC * 2);
constexpr size_t WS_OLOC = al(WS_LOGF + (size_t)M * 1024 * 4);
constexpr size_t WS_U = al(WS_OLOC + (size_t)SEQ * 1024 * 4);
constexpr size_t WS_DTOT = al(WS_U + (size_t)NSC * 8 * 16384 * 4);
constexpr size_t WS_SIN = al(WS_DTOT + (size_t)NSC * 8 * 128 * 4);
constexpr size_t WS_D = al(WS_SIN + (size_t)NSC * 8 * 16384 * 2);
constexpr size_t WS_E = al(WS_D + (size_t)M * 1024 * 2);
constexpr size_t WS_Y = al(WS_E + (size_t)SEQ * 1024 * 2);
constexpr size_t WS_MACC = al(WS_Y + (size_t)M * 4096 * 2);
constexpr size_t WS_MERGED = al(WS_MACC + (size_t)M * DM * 4);
constexpr size_t WS_ACT = al(WS_MERGED + (size_t)M * DM * 2);
constexpr size_t WS_KVRAW = al(WS_ACT + (size_t)M * DFF * 2);
constexpr size_t WS_KMEM = al(WS_KVRAW + (size_t)256 * 4096 * 4);
constexpr size_t WS_VMEMT = al(WS_KMEM + (size_t)DEPTH * 1024 * 256 * 2);
constexpr size_t WS_PART = al(WS_VMEMT + (size_t)DEPTH * 1024 * 256 * 2);
constexpr size_t WS_GF = al(WS_PART + (size_t)11 * NS * DM * 4);
constexpr size_t WS_END = al(WS_GF + (size_t)NPP * 32 * 16 * 512 * 16);

#ifdef EMU
#define LAS
#define ASMV(x)
#define WAVE_LDS_FENCE() emu_wave_sync()
#else
#define LAS __attribute__((address_space(3)))
#define ASMV(x) asm volatile(x ::: "memory")
#define WAVE_LDS_FENCE() asm volatile("s_waitcnt lgkmcnt(0)" ::: "memory")
#endif
#ifdef EMU
#define OPQ_V(x)
#define OPQ_S(x)
#else
#define OPQ_V(x) asm volatile("" : "+v"(x))
#define OPQ_S(x) asm volatile("" : "+s"(x))
#endif
typedef unsigned short bf16;
#ifdef EMU
__device__ __forceinline__ int hw_lane() { return threadIdx.x & 63; }
#else
__device__ __forceinline__ int hw_lane() { return (int)__builtin_amdgcn_mbcnt_hi(~0u, __builtin_amdgcn_mbcnt_lo(~0u, 0u)); }
#endif
template <class T> __device__ __forceinline__ T ldnt(const T* p) { return __builtin_nontemporal_load(p); }
template <class T> __device__ __forceinline__ void stnt(T* p, T v) { __builtin_nontemporal_store(v, p); }
typedef unsigned v4u __attribute__((ext_vector_type(4)));
typedef unsigned v2u __attribute__((ext_vector_type(2)));
typedef float f32x4 __attribute__((ext_vector_type(4)));
typedef float f32x2 __attribute__((ext_vector_type(2)));
typedef short bf16x8 __attribute__((ext_vector_type(8)));
constexpr int NT = 512, NWAVES = 8;
__device__ __forceinline__ unsigned f2bf(float f) { unsigned u = __builtin_bit_cast(unsigned, f); return (u + 0x7fffu + ((u >> 16) & 1u)) >> 16; }
__device__ __forceinline__ float bf2f(unsigned b) { return __builtin_bit_cast(float, b << 16); }
#ifdef EMU
__device__ __forceinline__ unsigned pk2(float lo, float hi) { return f2bf(lo) | (f2bf(hi) << 16); }
__device__ __forceinline__ float frcp(float x) { return 1.0f / x; }
__device__ __forceinline__ float fexp2(float x) { return exp2f(x); }
#else
__device__ __forceinline__ unsigned pk2(float lo, float hi) { unsigned r; asm("v_cvt_pk_bf16_f32 %0, %1, %2" : "=v"(r) : "v"(lo), "v"(hi)); return r; }
__device__ __forceinline__ float frcp(float x) { return __builtin_amdgcn_rcpf(x); }
__device__ __forceinline__ float fexp2(float x) { return __builtin_amdgcn_exp2f(x); }
#endif
__device__ __forceinline__ float bflo(unsigned w) { return __builtin_bit_cast(float, w << 16); }
__device__ __forceinline__ float bfhi(unsigned w) { return __builtin_bit_cast(float, w & 0xffff0000u); }
__device__ __forceinline__ void unpack8(v4u w, float (&f)[8]) { f[0] = bflo(w.x); f[1] = bfhi(w.x); f[2] = bflo(w.y); f[3] = bfhi(w.y); f[4] = bflo(w.z); f[5] = bfhi(w.z); f[6] = bflo(w.w); f[7] = bfhi(w.w); }
__device__ __forceinline__ v4u pack8(const float (&f)[8]) { v4u w; w.x = pk2(f[0], f[1]); w.y = pk2(f[2], f[3]); w.z = pk2(f[4], f[5]); w.w = pk2(f[6], f[7]); return w; }
__device__ __forceinline__ float wave_sum(float v) {
#pragma unroll
    for (int o = 1; o < 64; o <<= 1) v += __shfl_xor(v, o);
    return v;
}
#ifdef EMU
__device__ __forceinline__ float sigmoidf_(float x) { return 1.0f / (1.0f + __expf(-x)); }
#else
__device__ __forceinline__ float sigmoidf_(float x) { return __builtin_amdgcn_rcpf(1.0f + __builtin_amdgcn_exp2f(x * -1.44269504f)); }
#endif
__device__ __forceinline__ float siluf_(float x) { return x * sigmoidf_(x); }
__device__ __forceinline__ float gelu_as(float v) {
    const float av = fabsf(v), t = frcp(av * 0.2316418882f + 1.0f);
    float q = t * 0.5307027145f + (-0.7265760135f); q = q * t + 0.7107068705f; q = q * t + (-0.142248368f); q = q * t + 0.127414796f; q = q * t;
    const float e = fexp2((v * v) * (-0.72134752044f)), m = v * (q * e);
    return v < 0.f ? m : v - m;
}
#ifdef EMU
__device__ __forceinline__ unsigned cvt_pk_bf16(float lo, float hi) { return pk2(lo, hi); }
#else
__device__ __forceinline__ unsigned cvt_pk_bf16(float lo, float hi) { unsigned r; asm volatile("v_cvt_pk_bf16_f32 %0, %1, %2" : "=v"(r) : "v"(lo), "v"(hi)); return r; }
#endif

namespace pg8 {
constexpr int BM = 256, BK = 64, HALF = 128, HTB = HALF * BK * 2, STAGE_BYTES = 8 * HTB, NXCD = 8, WGM = 8;
__host__ __device__ __forceinline__ int lds_byte(int r, int c) { const int st = (r >> 4) * 2 + (c >> 5), rr = r & 15, cc = c & 31, ob = rr * 64 + cc * 2; return st * 1024 + (ob ^ (((ob >> 9) & 1) << 5)); }
__host__ __device__ __forceinline__ void stage_rc(int b, int& R, int& C) { const int st = b / 1024, sb = b % 1024, swz = sb ^ (((sb >> 9) & 1) << 5); R = (st >> 1) * 16 + swz / 64; C = (st & 1) * 32 + (swz % 64) / 2; }
__host__ __device__ __forceinline__ int perm32(int rho) { const int n = rho >> 4, i = rho & 15; return 8 * (i >> 2) + 4 * n + (i & 3); }
struct Unit { int pm, pn, acol, kofs, nt, ks; };
struct Gemm { const bf16* A; const bf16* Bt; int lda, ldb, K, wave0; };
__device__ __forceinline__ bool grid_order(int L, int nM, int nN, int& pm, int& pn) {
    const int nwg = nM * nN; if (L >= nwg) return false;
    int wgid = L; { const int q = nwg / NXCD, r = nwg % NXCD, xcd = wgid % NXCD, off = wgid / NXCD; wgid = (xcd < r ? xcd * (q + 1) : r * (q + 1) + (xcd - r) * q) + off; }
    const int nig = WGM * nN, gid = wgid / nig, fm = gid * WGM, gsz = (nM - fm) < WGM ? (nM - fm) : WGM;
    pm = fm + ((wgid % nig) % gsz); pn = (wgid % nig) / gsz; return true;
}
struct SchedGrid {
    int nM, nN, G, c, acol_step, ntf;
    __device__ __forceinline__ bool next(int i, Unit& u) const { const long L = (long)i * G + c; u.kofs = 0; u.nt = ntf; u.ks = -1; if (L >= (long)nM * nN) return false; if (!grid_order((int)L, nM, nN, u.pm, u.pn)) return false; u.acol = u.pn * acol_step; return true; }
};
struct SchedIn {
    int nM, nN, G, c, nextra, ntf, limit;
    __device__ __forceinline__ bool next(int i, Unit& u) const { const long L = (long)i * G + c; u.acol = 0; u.kofs = 0; u.nt = ntf; u.ks = -1; if (L >= limit) return false;
        if (L < (long)nM * nN) return grid_order((int)L, nM, nN, u.pm, u.pn);
        const int x = (int)(L - (long)nM * nN); if (x >= nextra) return false; u.pm = NPAN + x / 8; u.pn = nN + x; return true; }
};
struct SchedInS {
    int nMp, nMs, nN, G, c, nextra, ntf;
    __device__ __forceinline__ bool next(int i, Unit& u) const { const long L = (long)i * G + c; u.acol = 0; u.kofs = 0; u.nt = ntf; u.ks = -1;
        if (L < (long)nMs * nN) { u.pm = nMp + (int)(L / nN); u.pn = (int)(L % nN); return true; }
        const int x = (int)(L - (long)nMs * nN); if (x >= nextra) return false; u.pm = nMp + nMs + x / 8; u.pn = nN + x; return true; }
};
struct SchedBranch {
    int nM, G, c;
    __device__ __forceinline__ bool next(int i, Unit& u) const { const long su = (long)(i >> 2) * G + c; int pm, pd; u.kofs = 0; u.nt = 16; u.ks = -1; if (su >= (long)nM * 8) return false; if (!grid_order((int)su, nM, 8, pm, pd)) return false;
        const int n = i & 3; u.pm = pm; u.pn = n * 8 + pd; u.acol = n * 1024; return true; }
};

struct SchedBranchS {
    int nMp, nMs, G, c;
    __device__ __forceinline__ bool next(int i, Unit& u) const { const long L = (long)i * G + c; if (L >= (long)nMs * 64) return false;
        const int kh = (int)L & 1, n = ((int)L >> 1) & 3, tile = (int)L >> 3; u.pm = nMp + tile / 8; u.pn = n * 8 + (tile & 7); u.acol = n * 1024; u.kofs = kh * 512; u.nt = 8; u.ks = 2 * n + kh; return true; }
};
struct SchedSplit {
    int nMp, nMs, G, c, nsplit, ntf;
    __device__ __forceinline__ bool next(int i, Unit& u) const { const long L = (long)i * G + c; u.acol = 0;
        if (L < (long)nMp * 8) { u.kofs = 0; u.nt = ntf; u.ks = -1; return grid_order((int)L, nMp, 8, u.pm, u.pn); }
        const int x = (int)(L - (long)nMp * 8); if (x >= nMs * 8 * nsplit) return false;
        const int ks = x % nsplit, tile = x / nsplit; u.pm = nMp + tile / 8; u.pn = tile % 8; u.nt = ntf / nsplit; u.kofs = ks * u.nt * 64; u.ks = ks; return true; }
};

#ifdef EMU
static float emu_C[256 * 256];
static void emu_tile(const Gemm& g, const Unit& u) {
    const int KK = u.nt * 64; static std::vector<float> Af, Bf; Af.resize((size_t)256 * KK); Bf.resize((size_t)256 * KK);
    for (int r = 0; r < 256; ++r) for (int k = 0; k < KK; ++k) { Af[(size_t)r * KK + k] = bf2f(g.A[(size_t)(256 * u.pm + r) * g.lda + u.acol + u.kofs + k]); Bf[(size_t)r * KK + k] = bf2f(g.Bt[(size_t)(256 * u.pn + r) * g.ldb + u.kofs + k]); }
#pragma omp parallel for
    for (int r = 0; r < 256; ++r) for (int c = 0; c < 256; ++c) { const float* a = &Af[(size_t)r * KK]; const float* b = &Bf[(size_t)c * KK]; float s = 0.f; for (int k = 0; k < KK; ++k) s += a[k] * b[k]; emu_C[r * 256 + c] = s; }
}
template <class Epi, class Sched>
void gemm_phase(unsigned char* lds, const Gemm g, const Sched& S, const Epi& E) {
    const int tid = threadIdx.x, wid = tid >> 6, lane = tid & 63, wr = wid >> 2, wc = wid & 3, fr = lane & 15, fq = lane >> 4;
    for (int i = 0;; ++i) { Unit u; if (!S.next(i, u)) break;
        __syncthreads(); if (tid == 0) emu_tile(g, u); __syncthreads();
        f32x4 acc[2][2][4][2];
        for (int ai = 0; ai < 2; ++ai) for (int bj = 0; bj < 2; ++bj) for (int m = 0; m < 4; ++m) for (int n = 0; n < 2; ++n) for (int x = 0; x < 4; ++x) {
            const int row = 128 * ai + 64 * wr + 16 * m + fr, col = Epi::PERM ? 128 * bj + 32 * wc + 8 * fq + 4 * n + x : 128 * bj + 32 * wc + 16 * n + 4 * fq + x; acc[ai][bj][m][n][x] = emu_C[row * 256 + col]; }
        E(acc, u, wr, wc, fr, fq); }
    __syncthreads();
}
#else
template <class Epi, class Sched, bool ALIGN_EPI = true, bool SP2 = true>
__device__ __forceinline__ void gemm_phase(LAS unsigned char* lds, const Gemm g, const Sched& S, const Epi& E) {
    int tid = g.wave0 * 64 + hw_lane(); OPQ_V(tid); const int wid = __builtin_amdgcn_readfirstlane(tid >> 6), lane = tid & 63, wr = wid >> 2, wc = wid & 3, fr = lane & 15, fq = lane >> 4;
    unsigned voffA[2], voffB[2];
#pragma unroll
    for (int i = 0; i < 2; ++i) { int R, C; stage_rc(tid * 16 + i * 8192, R, C); const int Rb = Epi::PERM ? ((R & ~31) + perm32(R & 31)) : R;
        voffA[i] = (unsigned)(R * g.lda + C) * 2u; voffB[i] = (unsigned)(Rb * g.ldb + C) * 2u; }
    const size_t kstep = (size_t)(BK * 2);
    const size_t hstepA = (size_t)HALF * g.lda * 2, hstepB = (size_t)HALF * g.ldb * 2;
    const unsigned ldsw = (unsigned)wid * 1024u;
    const int aoff = lds_byte(wr * 64 + fr, fq * 8), boff = lds_byte(wc * 32 + fr, fq * 8);
#define PG8_SA(b, h) (((b) * 2 + (h)) * HTB)
#define PG8_SB(b, h) ((4 + (b) * 2 + (h)) * HTB)
#define PG8_STAGE(bufoff, gbase, voff) do { _Pragma("unroll") for (int _i = 0; _i < 2; ++_i) \
        __builtin_amdgcn_global_load_lds((const unsigned*)((const char*)(gbase) + (voff)[_i]), (LAS unsigned*)(lds + (bufoff) + ldsw + _i * 8192), 16, 0, 0); } while (0)
#define PG8_LDA(dst, b, h) do { _Pragma("unroll") for (int m = 0; m < 4; ++m) _Pragma("unroll") for (int k = 0; k < 2; ++k) dst[m][k] = *(const LAS bf16x8*)(lds + PG8_SA(b, h) + aoff + m * 2048 + k * 1024); } while (0)
#define PG8_LDB(dst, b, h) do { _Pragma("unroll") for (int n = 0; n < 2; ++n) _Pragma("unroll") for (int k = 0; k < 2; ++k) dst[n][k] = *(const LAS bf16x8*)(lds + PG8_SB(b, h) + boff + n * 2048 + k * 1024); } while (0)
#define PG8_MMA(ai, bj, At, Bt) do { __builtin_amdgcn_s_setprio(1); _Pragma("unroll") for (int m = 0; m < 4; ++m) _Pragma("unroll") for (int n = 0; n < 2; ++n) _Pragma("unroll") for (int k = 0; k < 2; ++k) \
        acc[ai][bj][m][n] = __builtin_amdgcn_mfma_f32_16x16x32_bf16(Bt[n][k], At[m][k], acc[ai][bj][m][n], 0, 0, 0); __builtin_amdgcn_s_setprio(0); } while (0)
#define PG8_WAIT_V(n) asm volatile("s_waitcnt vmcnt(" #n ")" ::: "memory")
#define PG8_WAIT_L(n) asm volatile("s_waitcnt lgkmcnt(" #n ")" ::: "memory")
#define PG8_BAR __builtin_amdgcn_s_barrier()
#define PG8_SCHED __builtin_amdgcn_sched_barrier(0)
    Unit cur, nxt; int ui = 0;
    if (!S.next(0, cur)) return;
    f32x4 acc[2][2][4][2];
#pragma unroll
    for (int a = 0; a < 2; ++a)
#pragma unroll
        for (int b = 0; b < 2; ++b)
#pragma unroll
            for (int m = 0; m < 4; ++m)
#pragma unroll
                for (int n = 0; n < 2; ++n) acc[a][b][m][n] = (f32x4){0.f, 0.f, 0.f, 0.f};
    bf16x8 At[4][2], B0[2][2], B1[2][2];
    const char* cA = (const char*)g.A + ((size_t)cur.pm * 256 * g.lda + cur.acol + cur.kofs) * 2; const char* cB = (const char*)g.Bt + ((size_t)cur.pn * 256 * g.ldb + cur.kofs) * 2;
    if constexpr (SP2) {
        PG8_STAGE(PG8_SB(0, 0), cB, voffB); PG8_STAGE(PG8_SB(0, 1), cB + hstepB, voffB); PG8_STAGE(PG8_SA(0, 0), cA, voffA); PG8_STAGE(PG8_SA(0, 1), cA + hstepA, voffA);
        if (wr == 1) PG8_BAR;
        PG8_WAIT_V(2); PG8_BAR;
        PG8_STAGE(PG8_SB(1, 0), cB + kstep, voffB); PG8_STAGE(PG8_SA(1, 0), cA + kstep, voffA); PG8_STAGE(PG8_SB(1, 1), cB + hstepB + kstep, voffB);
        PG8_WAIT_V(6); PG8_BAR;
    } else {
        PG8_STAGE(PG8_SB(0, 0), cB, voffB); PG8_STAGE(PG8_SA(0, 0), cA, voffA); PG8_STAGE(PG8_SB(0, 1), cB + hstepB, voffB); PG8_STAGE(PG8_SA(0, 1), cA + hstepA, voffA);
        if (wr == 1) PG8_BAR;
        PG8_WAIT_V(4); PG8_BAR;
        PG8_STAGE(PG8_SB(1, 0), cB + kstep, voffB); PG8_STAGE(PG8_SA(1, 0), cA + kstep, voffA); PG8_STAGE(PG8_SB(1, 1), cB + hstepB + kstep, voffB);
        PG8_WAIT_V(6); PG8_BAR;
    }
    for (;;) {
        const bool has_next = S.next(ui + 1, nxt);
        const char* nA = has_next ? (const char*)g.A + ((size_t)nxt.pm * 256 * g.lda + nxt.acol + nxt.kofs) * 2 : cA; const char* nB = has_next ? (const char*)g.Bt + ((size_t)nxt.pn * 256 * g.ldb + nxt.kofs) * 2 : cB;
        int nt = cur.nt; OPQ_S(nt);
        for (int t = 0; t < nt; t += 2) {
            const bool last = (t == nt - 2);
            const char* a1 = cA + (size_t)(t + 1) * kstep;
            const char* a2 = last ? nA : cA + (size_t)(t + 2) * kstep; const char* b2 = last ? nB : cB + (size_t)(t + 2) * kstep;
            const char* a3 = a2 + kstep; const char* b3 = b2 + kstep;
            if constexpr (SP2) {
            PG8_LDB(B0, 0, 0); PG8_LDB(B1, 0, 1); PG8_SCHED; PG8_LDA(At, 0, 0); PG8_STAGE(PG8_SA(1, 1), a1 + hstepA, voffA);
            PG8_WAIT_V(8); PG8_WAIT_L(0); PG8_BAR; PG8_MMA(0, 0, At, B0); PG8_MMA(0, 1, At, B1); PG8_BAR; PG8_SCHED;
            PG8_LDA(At, 0, 1); PG8_STAGE(PG8_SB(0, 0), b2, voffB); PG8_STAGE(PG8_SB(0, 1), b2 + hstepB, voffB); PG8_STAGE(PG8_SA(0, 0), a2, voffA);
            PG8_WAIT_V(8); PG8_WAIT_L(0); PG8_BAR; PG8_MMA(1, 0, At, B0); PG8_MMA(1, 1, At, B1); PG8_BAR; PG8_SCHED;
            PG8_LDB(B0, 1, 0); PG8_LDB(B1, 1, 1); PG8_SCHED; PG8_LDA(At, 1, 0); PG8_STAGE(PG8_SA(0, 1), a2 + hstepA, voffA);
            PG8_WAIT_V(8); PG8_WAIT_L(0); PG8_BAR; PG8_MMA(0, 0, At, B0); PG8_MMA(0, 1, At, B1); PG8_BAR; PG8_SCHED;
            PG8_LDA(At, 1, 1); PG8_STAGE(PG8_SB(1, 0), b3, voffB); PG8_STAGE(PG8_SB(1, 1), b3 + hstepB, voffB); PG8_STAGE(PG8_SA(1, 0), a3, voffA);
            PG8_WAIT_V(8); PG8_WAIT_L(0); PG8_BAR; PG8_MMA(1, 0, At, B0); PG8_MMA(1, 1, At, B1); PG8_BAR; PG8_SCHED;
            } else {
            PG8_LDB(B0, 0, 0); PG8_SCHED; PG8_LDA(At, 0, 0); PG8_STAGE(PG8_SA(1, 1), a1 + hstepA, voffA);
            PG8_WAIT_L(8); PG8_BAR; PG8_WAIT_L(0); PG8_MMA(0, 0, At, B0); PG8_BAR; PG8_SCHED;
            PG8_LDB(B1, 0, 1); PG8_STAGE(PG8_SB(0, 0), b2, voffB);
            PG8_BAR; PG8_WAIT_L(0); PG8_MMA(0, 1, At, B1); PG8_BAR;
            PG8_LDA(At, 0, 1); PG8_STAGE(PG8_SA(0, 0), a2, voffA);
            PG8_BAR; PG8_WAIT_L(0); PG8_MMA(1, 0, At, B0); PG8_BAR; PG8_SCHED;
            PG8_STAGE(PG8_SB(0, 1), b2 + hstepB, voffB);
            PG8_WAIT_V(6); PG8_BAR; PG8_MMA(1, 1, At, B1); PG8_BAR;
            PG8_LDB(B0, 1, 0); PG8_SCHED; PG8_LDA(At, 1, 0); PG8_STAGE(PG8_SA(0, 1), a2 + hstepA, voffA);
            PG8_WAIT_L(8); PG8_BAR; PG8_WAIT_L(0); PG8_MMA(0, 0, At, B0); PG8_BAR; PG8_SCHED;
            PG8_LDB(B1, 1, 1); PG8_STAGE(PG8_SB(1, 0), b3, voffB);
            PG8_BAR; PG8_WAIT_L(0); PG8_MMA(0, 1, At, B1); PG8_BAR;
            PG8_LDA(At, 1, 1); PG8_STAGE(PG8_SA(1, 0), a3, voffA);
            PG8_BAR; PG8_WAIT_L(0); PG8_MMA(1, 0, At, B0); PG8_BAR; PG8_SCHED;
            PG8_STAGE(PG8_SB(1, 1), b3 + hstepB, voffB);
            PG8_WAIT_V(6); PG8_BAR; PG8_MMA(1, 1, At, B1); PG8_BAR;
                    }
        }
        if constexpr (ALIGN_EPI) { if (wr == 0) PG8_BAR; }
        E(acc, cur, wr, wc, fr, fq);
        if (!has_next) break;
#pragma unroll
        for (int a = 0; a < 2; ++a)
#pragma unroll
            for (int b = 0; b < 2; ++b)
#pragma unroll
                for (int m = 0; m < 4; ++m)
#pragma unroll
                    for (int n = 0; n < 2; ++n) acc[a][b][m][n] = (f32x4){0.f, 0.f, 0.f, 0.f};
        cur = nxt; cA = nA; cB = nB; ++ui;
        if constexpr (ALIGN_EPI) { if (wr == 1) PG8_BAR; }
    }
    PG8_WAIT_V(0);
    if constexpr (!ALIGN_EPI) { if (wr == 0) PG8_BAR; }
    PG8_BAR;
#undef PG8_SA
#undef PG8_SB
#undef PG8_STAGE
#undef PG8_LDA
#undef PG8_LDB
#undef PG8_MMA
#undef PG8_WAIT_V
#undef PG8_WAIT_L
#undef PG8_BAR
#undef PG8_SCHED
}
#endif
typedef f32x4 Acc[2][2][4][2];
struct EpiIn {
    static constexpr bool PERM = true;
    bf16* P; float* LOGF; const float* lb; float* KVRAW; v4u* GF;
    __device__ __forceinline__ void operator()(const Acc& acc, const Unit& u, int wr, int wc, int fr, int fq) const {
        int frv = fr; OPQ_V(frv);
        const int rl = wr * 64 + frv, cl = wc * 32 + 8 * fq;
        if (u.pn >= INC / 256) {
            const int cb = (u.pn - INC / 256) * 256 + cl;
#pragma unroll
            for (int ai = 0; ai < 2; ++ai)
#pragma unroll
                for (int m = 0; m < 4; ++m) { float* rp = KVRAW + (size_t)(rl + ai * 128 + m * 16) * 4096 + cb;
#pragma unroll
                    for (int bj = 0; bj < 2; ++bj) { *(f32x4*)(rp + bj * 128) = acc[ai][bj][m][0]; *(f32x4*)(rp + bj * 128 + 4) = acc[ai][bj][m][1]; } }
            return;
        }
        const int pn = u.pn; const int kind = (pn < 4) ? 1 : (pn < 8) ? 3 : (pn < 12) ? 0 : (pn < 16) ? 1 : (pn < 30) ? 0 : 2;
        if (pn >= 30 && u.pm < NPP) {
            v4u* gf = GF + ((size_t)(u.pm * 32 + (pn - 30)) * 16) * 512 + (wr * 4 + wc) * 64 + fq * 16 + frv;
#pragma unroll
            for (int ai = 0; ai < 2; ++ai)
#pragma unroll
                for (int m = 0; m < 4; ++m)
#pragma unroll
                    for (int bj = 0; bj < 2; ++bj) { f32x4 v0 = acc[ai][bj][m][0], v1 = acc[ai][bj][m][1];
#pragma unroll
                        for (int x = 0; x < 4; ++x) { v0[x] = sigmoidf_(v0[x]); v1[x] = sigmoidf_(v1[x]); }
                        v4u w; w.x = cvt_pk_bf16(v0[0], v0[1]); w.y = cvt_pk_bf16(v0[2], v0[3]); w.z = cvt_pk_bf16(v1[0], v1[1]); w.w = cvt_pk_bf16(v1[2], v1[3]);
                        int k = ai * 8 + m * 2 + bj; OPQ_S(k); stnt(gf + (size_t)k * 512, w); }
            return;
        }
        const int row0 = u.pm * 256 + rl, col0 = pn * 256 + cl;
        if (kind == 3) {
#pragma unroll
            for (int bj = 0; bj < 2; ++bj) { const f32x4 l0 = *(const f32x4*)(lb + col0 - C_FA + bj * 128), l1 = *(const f32x4*)(lb + col0 - C_FA + bj * 128 + 4);
#pragma unroll
                for (int ai = 0; ai < 2; ++ai)
#pragma unroll
                    for (int m = 0; m < 4; ++m) { float* rp = LOGF + (size_t)(row0 + ai * 128 + m * 16) * 1024 + (col0 - C_FA) + bj * 128; f32x4 o0, o1;
#pragma unroll
                        for (int x = 0; x < 4; ++x) { o0[x] = logf(l0[x] + (1.f - l0[x]) * sigmoidf_(acc[ai][bj][m][0][x])); o1[x] = logf(l1[x] + (1.f - l1[x]) * sigmoidf_(acc[ai][bj][m][1][x])); }
                        *(f32x4*)rp = o0; *(f32x4*)(rp + 4) = o1; } }
            return;
        }
#pragma unroll
        for (int ai = 0; ai < 2; ++ai)
#pragma unroll
            for (int m = 0; m < 4; ++m) { bf16* rp = P + (size_t)(row0 + ai * 128 + m * 16) * INC + col0;
#pragma unroll
                for (int bj = 0; bj < 2; ++bj) { f32x4 v0 = acc[ai][bj][m][0], v1 = acc[ai][bj][m][1];
                    if (kind == 1) {
#pragma unroll
                        for (int x = 0; x < 4; ++x) { v0[x] = siluf_(v0[x]); v1[x] = siluf_(v1[x]); } }
                    if (kind == 2) {
#pragma unroll
                        for (int x = 0; x < 4; ++x) { v0[x] = sigmoidf_(v0[x]); v1[x] = sigmoidf_(v1[x]); } }
                    v4u w; w.x = cvt_pk_bf16(v0[0], v0[1]); w.y = cvt_pk_bf16(v0[2], v0[3]); w.z = cvt_pk_bf16(v1[0], v1[1]); w.w = cvt_pk_bf16(v1[2], v1[3]);
                    *(v4u*)(rp + bj * 128) = w; } }
    }
};
struct EpiBf16S {
    static constexpr bool PERM = true;
    bf16* O; int ldc, cbase, cstep; const float* colscale; const float* rowsum; int rs_stride;
    __device__ __forceinline__ void operator()(const Acc& acc, const Unit& u, int wr, int wc, int fr, int fq) const {
        const int row0 = u.pm * 256 + wr * 64 + fr, cl = wc * 32 + 8 * fq, col0 = cbase + u.pn * cstep + cl;
        f32x4 s0[2], s1[2];
#pragma unroll
        for (int bj = 0; bj < 2; ++bj) { if (colscale) { s0[bj] = *(const f32x4*)(colscale + u.pn * 256 + cl + bj * 128); s1[bj] = *(const f32x4*)(colscale + u.pn * 256 + cl + bj * 128 + 4); } else { s0[bj] = (f32x4){1.f, 1.f, 1.f, 1.f}; s1[bj] = s0[bj]; } }
#pragma unroll
        for (int ai = 0; ai < 2; ++ai)
#pragma unroll
            for (int m = 0; m < 4; ++m) { const int row = row0 + ai * 128 + m * 16; bf16* rp = O + (size_t)row * ldc + col0;
                const float rs = rowsum ? 1.0f / rowsum[(size_t)row * rs_stride + u.pn] : 1.0f;
#pragma unroll
                for (int bj = 0; bj < 2; ++bj) { const f32x4 v0 = acc[ai][bj][m][0] * s0[bj] * rs, v1 = acc[ai][bj][m][1] * s1[bj] * rs;
                    v4u w; w.x = cvt_pk_bf16(v0[0], v0[1]); w.y = cvt_pk_bf16(v0[2], v0[3]); w.z = cvt_pk_bf16(v1[0], v1[1]); w.w = cvt_pk_bf16(v1[2], v1[3]);
                    *(v4u*)(rp + bj * 128) = w; } }
    }
};
struct EpiMemS {
    static constexpr bool PERM = true;
    bf16* E; float* rowsum;
    __device__ __forceinline__ void operator()(const Acc& acc, const Unit& u, int wr, int wc, int fr, int fq) const {
        const int row0 = u.pm * 256 + wr * 64 + fr, col0 = u.pn * 256 + wc * 32 + 8 * fq;
#pragma unroll
        for (int ai = 0; ai < 2; ++ai)
#pragma unroll
            for (int m = 0; m < 4; ++m) { const int row = row0 + ai * 128 + m * 16; bf16* rp = E + (size_t)row * 1024 + col0; float s = 0.f;
#pragma unroll
                for (int bj = 0; bj < 2; ++bj) { f32x4 v0, v1;
#pragma unroll
                    for (int x = 0; x < 4; ++x) { v0[x] = __expf(acc[ai][bj][m][0][x]); v1[x] = __expf(acc[ai][bj][m][1][x]); }
                    s += (v0[0] + v0[1]) + (v0[2] + v0[3]) + (v1[0] + v1[1]) + (v1[2] + v1[3]);
                    v4u w; w.x = cvt_pk_bf16(v0[0], v0[1]); w.y = cvt_pk_bf16(v0[2], v0[3]); w.z = cvt_pk_bf16(v1[0], v1[1]); w.w = cvt_pk_bf16(v1[2], v1[3]);
                    *(v4u*)(rp + bj * 128) = w; }
                s += __shfl_xor(s, 16); s += __shfl_xor(s, 32);
                if (fq == 0) atomicAdd(rowsum + (size_t)row * 4 + u.pn, s); }
    }
};
struct EpiBranch {
    static constexpr bool PERM = true;
    const bf16* P; const v4u* GF; v4u* MS; bf16* MERGED; float* part;
    __device__ __forceinline__ void operator()(const Acc& acc, const Unit& u, int wr, int wc, int fr, int fq) const {
        const int n = u.pn >> 3, pd = u.pn & 7; const int row0 = u.pm * 256 + wr * 64 + fr, col0 = pd * 256 + wc * 32 + 8 * fq;
        if (u.ks >= 0) {
            float* pb = part + ((size_t)u.ks * NS - SEQ) * DM;
#pragma unroll
            for (int ai = 0; ai < 2; ++ai) { v4u gq[4][2];
#pragma unroll
                for (int m = 0; m < 4; ++m)
#pragma unroll
                    for (int bj = 0; bj < 2; ++bj) gq[m][bj] = *(const v4u*)(P + (size_t)(row0 + ai * 128 + m * 16) * INC + C_GZ + n * 2048 + col0 + bj * 128);
#pragma unroll
                for (int m = 0; m < 4; ++m) { const int row = row0 + ai * 128 + m * 16;
#pragma unroll
                    for (int bj = 0; bj < 2; ++bj) { float g[8]; unpack8(gq[m][bj], g);
                        f32x4 v0 = acc[ai][bj][m][0], v1 = acc[ai][bj][m][1];
#pragma unroll
                        for (int x = 0; x < 4; ++x) { v0[x] *= g[x]; v1[x] *= g[4 + x]; }
                        float* mp = pb + (size_t)row * DM + col0 + bj * 128; *(f32x4*)mp = v0; *(f32x4*)(mp + 4) = v1; } } }
            return; }
        const int ln = (wr * 4 + wc) * 64 + fq * 16 + fr;
        const v4u* gf = GF + ((size_t)(u.pm * 32 + u.pn) * 16) * 512 + ln; v4u* ms = MS + ln;
#pragma unroll
        for (int ai = 0; ai < 2; ++ai)
#pragma unroll
            for (int mh = 0; mh < 2; ++mh) {
                int kb = ai * 8 + mh * 4; OPQ_S(kb);
                v4u gq[4], sq[4];
#pragma unroll
                for (int j = 0; j < 4; ++j) { gq[j] = ldnt(gf + (size_t)(kb + j) * 512); if (n > 0) sq[j] = ms[(size_t)(kb + j) * 512]; }
#pragma unroll
                for (int j = 0; j < 4; ++j) { const int m = mh * 2 + (j >> 1), bj = j & 1; float g[8]; unpack8(gq[j], g);
                    f32x4 v0 = acc[ai][bj][m][0], v1 = acc[ai][bj][m][1];
#pragma unroll
                    for (int x = 0; x < 4; ++x) { v0[x] *= g[x]; v1[x] *= g[4 + x]; }
                    if (n > 0) { float r[8]; unpack8(sq[j], r);
#pragma unroll
                        for (int x = 0; x < 4; ++x) { v0[x] += r[x]; v1[x] += r[4 + x]; } }
                    if (n < 3) { v4u w; w.x = cvt_pk_bf16(v0[0], v0[1]); w.y = cvt_pk_bf16(v0[2], v0[3]); w.z = cvt_pk_bf16(v1[0], v1[1]); w.w = cvt_pk_bf16(v1[2], v1[3]); ms[(size_t)(kb + j) * 512] = w; }
                    else { const int row = row0 + ai * 128 + m * 16; v4u w; w.x = cvt_pk_bf16(v0[0], v0[1]); w.y = cvt_pk_bf16(v0[2], v0[3]); w.z = cvt_pk_bf16(v1[0], v1[1]); w.w = cvt_pk_bf16(v1[2], v1[3]);
                        *(v4u*)(MERGED + (size_t)row * DM + col0 + bj * 128) = w; } }
            }
    }
};
struct EpiRes {
    static constexpr bool PERM = false;
    const float* res_p; const float* res_s; float* out; float* part;
    __device__ __forceinline__ void operator()(const Acc& acc, const Unit& u, int wr, int wc, int fr, int fq) const {
        const int row0 = u.pm * 256 + wr * 64 + fr, col0 = u.pn * 256 + wc * 32 + 4 * fq;
        if (u.ks >= 0) { float* pb = part + ((size_t)u.ks * NS - SEQ) * DM;
#pragma unroll
            for (int ai = 0; ai < 2; ++ai)
#pragma unroll
                for (int m = 0; m < 4; ++m) { const size_t off = (size_t)(row0 + ai * 128 + m * 16) * DM + col0;
#pragma unroll
                    for (int bj = 0; bj < 2; ++bj)
#pragma unroll
                        for (int n = 0; n < 2; ++n) *(f32x4*)(pb + off + bj * 128 + n * 16) = acc[ai][bj][m][n]; }
            return; }
        const float* rbase = (u.pm * 256 < SEQ) ? res_p : res_s - (size_t)SEQ * DM;
#pragma unroll
        for (int ai = 0; ai < 2; ++ai)
#pragma unroll
            for (int mh = 0; mh < 2; ++mh) { f32x4 r[2][2][2];
#pragma unroll
                for (int mm = 0; mm < 2; ++mm) { const size_t off = (size_t)(row0 + ai * 128 + (mh * 2 + mm) * 16) * DM + col0;
#pragma unroll
                    for (int bj = 0; bj < 2; ++bj)
#pragma unroll
                        for (int n = 0; n < 2; ++n) r[mm][bj][n] = ldnt((const f32x4*)(rbase + off + bj * 128 + n * 16)); }
#pragma unroll
                for (int mm = 0; mm < 2; ++mm) { const size_t off = (size_t)(row0 + ai * 128 + (mh * 2 + mm) * 16) * DM + col0;
#pragma unroll
                    for (int bj = 0; bj < 2; ++bj)
#pragma unroll
                        for (int n = 0; n < 2; ++n) *(f32x4*)(out + off + bj * 128 + n * 16) = r[mm][bj][n] + acc[ai][bj][mh * 2 + mm][n]; } }
    }
};
}

#ifndef EMU
#define XB_TMO      128
#define XB_XCNT(j)  (256  + 64 * (j))
#define XB_XSUB(j)  (1280 + 64 * (j))
#define XB_XGEN(j)  (2304 + 64 * (j))
#define XB_TOP      3328
#define XB_TOPGEN   3392
#define XCD_BAR_WORDS 3456
#define XB_SPIN_CAP (1u << 18)
__device__ __forceinline__ unsigned xb_ld(unsigned* p)              { return __hip_atomic_load(p, __ATOMIC_RELAXED, __HIP_MEMORY_SCOPE_AGENT); }
__device__ __forceinline__ unsigned xb_add(unsigned* p, unsigned v) { return __hip_atomic_fetch_add(p, v, __ATOMIC_RELAXED, __HIP_MEMORY_SCOPE_AGENT); }
__device__ __forceinline__ unsigned xb_xcc_id() { return (unsigned)__builtin_amdgcn_s_getreg((3 << 11) | 20) & 0xFu; }
#define XB_SPIN(cond, bar) do { unsigned _sp = 0; while (cond) { __builtin_amdgcn_s_sleep(1); \
    if ((++_sp & 255u) == 0u) { if (xb_ld(&(bar)[XB_TMO])) break; if (_sp > XB_SPIN_CAP) { atomicAdd(&(bar)[XB_TMO], 1u); break; } } } } while (0)
struct XcdBarrier { unsigned* bar; unsigned x; volatile LAS unsigned* st; int w0; };
__device__ __forceinline__ XcdBarrier xcd_barrier_post(unsigned* bar, volatile LAS unsigned* st) {
    XcdBarrier b; b.bar = bar; b.x = xb_xcc_id(); b.st = st;
    if (threadIdx.x == 0) (void)xb_add(&bar[XB_XCNT(b.x)], 1u);
    return b;
}
__device__ __forceinline__ void xcd_barrier_complete(unsigned* bar, unsigned x, unsigned& nloc, unsigned& nx) {
    const unsigned G = gridDim.x * gridDim.y * gridDim.z;
    unsigned sum, cnt, mine, sp = 0u;
    for (;;) {
        sum = 0u; cnt = 0u; mine = 0u;
#pragma unroll
        for (unsigned j = 0; j < 16; ++j) { const unsigned c = xb_ld(&bar[XB_XCNT(j)]); sum += c; cnt += (c > 0u) ? 1u : 0u; mine = (j == x) ? c : mine; }
        if (sum == G) break;
        __builtin_amdgcn_s_sleep(1);
        if ((++sp & 255u) == 0u) { if (xb_ld(&bar[XB_TMO])) break; if (sp > XB_SPIN_CAP) { atomicAdd(&bar[XB_TMO], 1u); break; } }
    }
    nloc = mine > 0u ? mine : 1u; nx = cnt > 0u ? cnt : 1u;
}
__device__ __forceinline__ void xcd_barrier(const XcdBarrier& b) {
    asm volatile("s_waitcnt vmcnt(0)" ::: "memory");
    __syncthreads();
    if (b.w0 == 0 && hw_lane() == 0) {
        unsigned* bar = b.bar;
        __builtin_amdgcn_s_waitcnt(0);
        unsigned nloc = b.st[0], nx = b.st[1];
        if (nloc == 0u) { xcd_barrier_complete(bar, b.x, nloc, nx); b.st[0] = nloc; b.st[1] = nx; }
        const unsigned old = xb_add(&bar[XB_XSUB(b.x)], 1u);
        const unsigned gen = old / nloc;
        if (old + 1u == (gen + 1u) * nloc) {
            __builtin_amdgcn_fence(__ATOMIC_RELEASE, "agent");
            asm volatile("s_waitcnt vmcnt(0)" ::: "memory");
            const unsigned og = xb_add(&bar[XB_TOP], 1u);
            const unsigned tg = og / nx;
            __builtin_amdgcn_fence(__ATOMIC_ACQUIRE, "agent");
            if (og + 1u == (tg + 1u) * nx) xb_add(&bar[XB_TOPGEN], 1u);
            else XB_SPIN(xb_ld(&bar[XB_TOPGEN]) == tg, bar);
            xb_add(&bar[XB_XGEN(b.x)], 1u);
            asm volatile("s_waitcnt vmcnt(0)" ::: "memory");
        } else {
            __builtin_amdgcn_fence(__ATOMIC_ACQUIRE, "agent");
            XB_SPIN(xb_ld(&bar[XB_XGEN(b.x)]) == gen, bar);
            asm volatile("s_waitcnt vmcnt(0)" ::: "memory");
        }
    }
    __syncthreads();
}
#endif

struct Ctx {
    LAS unsigned char* lds; int G, bid, wave0;
    const float *x_prompt, *x_sample, *mem_prompt, *state_hgrn, *cache_pool, *cache_swa_k, *cache_swa_v, *state_conv, *cache_mem_k, *cache_mem_v;
    const float *norm1_g, *w_in, *hgrn_lb, *hgrn_norm_g, *pool_w, *pool_scale, *swa_qnorm_g, *swa_knorm_g, *swa_sinks, *mem_norm_g, *w_mem_kv, *mem_qnorm_g, *mem_knorm_g,
        *w_branch, *w_o, *norm2_g, *w_up, *conv_w, *conv_b, *w_down;
    float* out; unsigned char* ws;
};
#define WSP(T, off) ((T*)(c.ws + (off)))
__device__ __forceinline__ bool in_phase(int lo, int hi, int k) { OPQ_S(lo); OPQ_S(hi); return lo <= k && k < hi; }
#define PHASE_IDS() int ptid = c.wave0 * 64 + hw_lane(); OPQ_V(ptid); const int plane = ptid & 63, pwave = __builtin_amdgcn_readfirstlane(ptid >> 6); (void)plane; (void)pwave

struct Args { const float* in[30]; float* out; unsigned char* ws; int ph_lo, ph_hi; };
#ifdef EMU
__device__ __forceinline__ Ctx make_ctx(const Args& A, unsigned char* lds, int wave0) {
#define CTXF(i) A.in[i]
    Ctx c; c.lds = lds; c.out = A.out; c.ws = A.ws;
#else
__device__ __forceinline__ Ctx make_ctx(const __attribute__((address_space(4))) char* kp, LAS unsigned char* lds, int wave0) {
    OPQ_S(kp);
#define CTXF(i) (((const float* const __attribute__((address_space(4)))*)kp)[i])
    Ctx c; c.lds = lds; c.out = ((float* const __attribute__((address_space(4)))*)kp)[30]; c.ws = ((unsigned char* const __attribute__((address_space(4)))*)kp)[31];
#endif
    c.G = gridDim.x; c.bid = blockIdx.x; c.wave0 = wave0;
    c.x_prompt = CTXF(0); c.x_sample = CTXF(1); c.mem_prompt = CTXF(2); c.state_hgrn = CTXF(3); c.cache_pool = CTXF(4); c.cache_swa_k = CTXF(5); c.cache_swa_v = CTXF(6);
    c.state_conv = CTXF(7); c.cache_mem_k = CTXF(8); c.cache_mem_v = CTXF(9); c.norm1_g = CTXF(10); c.w_in = CTXF(11); c.hgrn_lb = CTXF(12); c.hgrn_norm_g = CTXF(13);
    c.pool_w = CTXF(14); c.pool_scale = CTXF(15); c.swa_qnorm_g = CTXF(16); c.swa_knorm_g = CTXF(17); c.swa_sinks = CTXF(18); c.mem_norm_g = CTXF(19); c.w_mem_kv = CTXF(20);
    c.mem_qnorm_g = CTXF(21); c.mem_knorm_g = CTXF(22); c.w_branch = CTXF(23); c.w_o = CTXF(24); c.norm2_g = CTXF(25); c.w_up = CTXF(26); c.conv_w = CTXF(27); c.conv_b = CTXF(28); c.w_down = CTXF(29);
#undef CTXF
    return c;
}

constexpr int TI_WIN = (DM / 64) * (INC / 32), TI_MKV = (DM / 64) * (2048 / 32), TI_BR = (1024 / 64) * (DM / 32), TI_WO = (DM / 64) * (DM / 32), TI_UP = (DM / 64) * (2 * DFF / 32), TI_DN = (DFF / 64) * (DM / 32), TI_PL = (256 / 64) * (256 / 32);
constexpr int TI_LAYER = TI_WIN + TI_MKV + 4 * TI_BR + TI_WO + TI_UP + TI_DN + 4 * TI_PL, TI_TOTAL = DEPTH * TI_LAYER;
struct TrItem { const float* src; bf16* dst; int ldw, K; };
template <class CtxT> __device__ __forceinline__ TrItem tr_decode(const CtxT& c, int item, int lane) {
    const int l = item / TI_LAYER; int r = item % TI_LAYER; const float* W; bf16* WT; int ldw, K, N;
    if (r < TI_WIN) { W = c.w_in + (size_t)l * DM * INC; ldw = INC; K = DM; N = INC; WT = l == 0 ? WSP(bf16, WS_WIN) : WSP(bf16, WS_WIN1); }
    else if ((r -= TI_WIN) < TI_MKV) { W = c.w_mem_kv + (size_t)l * DM * 2048; ldw = 2048; K = DM; N = 2048; WT = WSP(bf16, WS_WIN) + (size_t)(INC + 2048 * l) * DM; }
    else if ((r -= TI_MKV) < 4 * TI_BR) { const int n = r / TI_BR; r -= n * TI_BR; W = c.w_branch + ((size_t)l * 4 + n) * 1024 * DM; ldw = DM; K = 1024; N = DM; WT = WSP(bf16, WS_WBR) + ((size_t)l * 4 + n) * 2048 * 1024; }
    else if ((r -= 4 * TI_BR) < TI_WO) { W = c.w_o + (size_t)l * DM * DM; ldw = DM; K = DM; N = DM; WT = WSP(bf16, WS_WO) + (size_t)l * DM * DM; }
    else if ((r -= TI_WO) < TI_UP) { W = c.w_up + (size_t)l * DM * 2 * DFF; ldw = 2 * DFF; K = DM; N = 2 * DFF; WT = WSP(bf16, WS_WUP) + (size_t)l * 2 * DFF * DM; }
    else if ((r -= TI_UP) < TI_DN) { W = c.w_down + (size_t)l * DFF * DM; ldw = DM; K = DFF; N = DM; WT = WSP(bf16, WS_WDN) + (size_t)l * DM * DFF; }
    else { r -= TI_DN; const int g = r / TI_PL; r -= g * TI_PL; W = c.pool_w + ((size_t)l * 4 + g) * 65536; ldw = 256; K = 256; N = 256; WT = WSP(bf16, WS_WPL) + ((size_t)l * 4 + g) * 65536; }
    const int nblk = N / 32, kb = r / nblk, nb = r % nblk, k0 = 64 * kb, n0 = 32 * nb;
    TrItem t; t.src = W + (size_t)(k0 + (lane >> 3)) * ldw + n0 + (lane & 7) * 4; t.dst = WT + (size_t)(n0 + (lane >> 3)) * K + k0 + 8 * (lane & 7); t.ldw = ldw; t.K = K; return t;
}
__device__ __forceinline__ void tr_load(const TrItem& t, f32x4 (&r)[8]) {
#pragma unroll
    for (int i = 0; i < 8; ++i) r[i] = ldnt((const f32x4*)(t.src + (size_t)(8 * i) * t.ldw));
}
__device__ __forceinline__ void tr_store(const TrItem& t, const f32x4 (&r)[8], LAS float* scr, int lane, bool nts) {
#pragma unroll
    for (int i = 0; i < 8; ++i) { const int kk = 8 * i + (lane >> 3), n4 = (lane & 7) * 4; scr[kk * 33 + n4] = r[i].x; scr[kk * 33 + n4 + 1] = r[i].y; scr[kk * 33 + n4 + 2] = r[i].z; scr[kk * 33 + n4 + 3] = r[i].w; }
    WAVE_LDS_FENCE();
    const int cc = lane & 7;
#pragma unroll
    for (int j = 0; j < 4; ++j) { const int n = (lane >> 3) + 8 * j; const LAS float* s = scr + (8 * cc) * 33 + n;
        v4u o; o.x = pk2(s[0 * 33], s[1 * 33]); o.y = pk2(s[2 * 33], s[3 * 33]); o.z = pk2(s[4 * 33], s[5 * 33]); o.w = pk2(s[6 * 33], s[7 * 33]);
        if (nts) stnt((v4u*)(t.dst + (size_t)(8 * j) * t.K), o); else *(v4u*)(t.dst + (size_t)(8 * j) * t.K) = o; }
    WAVE_LDS_FENCE();
}
constexpr int TI_REST = TI_LAYER - TI_WIN - TI_MKV;
constexpr int TI_PART0 = TI_WIN + 2 * TI_MKV, TI_PART1 = TI_REST + TI_WIN, TI_PART2 = TI_REST;
static_assert(TI_PART0 + TI_PART1 + TI_PART2 == TI_TOTAL, "conversion parts");
__device__ __forceinline__ int tr_map(int j, int part) {
    if (part == 0) return j < TI_WIN + TI_MKV ? j : TI_LAYER + TI_WIN + (j - TI_WIN - TI_MKV);
    if (part == 1) return j < TI_REST ? TI_WIN + TI_MKV + j : TI_LAYER + (j - TI_REST);
    return TI_LAYER + TI_WIN + TI_MKV + j;
}
template <class CtxT> __device__ __forceinline__ void tr_stream(const CtxT& c, LAS float* scr, int wid, int nw, int part, int lane, int j0 = 0, int j1 = 1 << 30) {
    const int ptotal = part == 0 ? TI_PART0 : part == 1 ? TI_PART1 : TI_PART2; const int total = j1 < ptotal ? j1 : ptotal;
    int it = j0 + wid; f32x4 ra[8], rb[8]; TrItem ta, tb; ta = tr_decode(c, tr_map(it < total ? it : 0, part), lane); tb = ta;
    if (it < total) tr_load(ta, ra);
    while (it < total) { const int nit = it + nw;
        if (nit < total) { tb = tr_decode(c, tr_map(nit, part), lane); tr_load(tb, rb); }
        tr_store(ta, ra, scr, lane, part != 0);
#pragma unroll
        for (int i = 0; i < 8; ++i) ra[i] = rb[i];
        ta = tb; it = nit; }
}
__device__ __forceinline__ void rms_row(const float* xrow, const float* g, bf16* orow, int lane) {
    const f32x4* xr = (const f32x4*)xrow + lane; const f32x4* gr = (const f32x4*)g + lane;
    f32x4 v[8]; float s = 0.f;
#pragma unroll
    for (int j = 0; j < 8; ++j) { v[j] = xr[64 * j]; s += (v[j].x * v[j].x + v[j].y * v[j].y) + (v[j].z * v[j].z + v[j].w * v[j].w); }
    const float rstd = 1.0f / sqrtf(wave_sum(s) * (1.f / DM) + EPS);
    v2u* o8 = (v2u*)orow + lane;
#pragma unroll
    for (int j = 0; j < 8; ++j) { const f32x4 gg = gr[64 * j]; v2u w; w.x = pk2(v[j].x * rstd * gg.x, v[j].y * rstd * gg.y); w.y = pk2(v[j].z * rstd * gg.z, v[j].w * rstd * gg.w); o8[64 * j] = w; }
}
__device__ __forceinline__ void rms_row2(const float* x0, bf16* o0, const float* x1, bf16* o1, const float* g, int lane) {
    const f32x4* xa = (const f32x4*)x0 + lane; const f32x4* xb = (const f32x4*)(x1 ? x1 : x0) + lane; const f32x4* gr = (const f32x4*)g + lane;
    f32x4 va[8], vb[8]; float sa = 0.f, sb = 0.f;
#pragma unroll
    for (int j = 0; j < 8; ++j) { va[j] = xa[64 * j]; vb[j] = xb[64 * j]; }
#pragma unroll
    for (int j = 0; j < 8; ++j) { sa += (va[j].x * va[j].x + va[j].y * va[j].y) + (va[j].z * va[j].z + va[j].w * va[j].w); sb += (vb[j].x * vb[j].x + vb[j].y * vb[j].y) + (vb[j].z * vb[j].z + vb[j].w * vb[j].w); }
    const float ra = 1.0f / sqrtf(wave_sum(sa) * (1.f / DM) + EPS), rb = 1.0f / sqrtf(wave_sum(sb) * (1.f / DM) + EPS);
    v2u* pa = (v2u*)o0 + lane; v2u* pb = (v2u*)o1 + lane;
#pragma unroll
    for (int j = 0; j < 8; ++j) { const f32x4 gg = gr[64 * j]; pa[64 * j] = (v2u){pk2(va[j].x * ra * gg.x, va[j].y * ra * gg.y), pk2(va[j].z * ra * gg.z, va[j].w * ra * gg.w)};
        if (x1) pb[64 * j] = (v2u){pk2(vb[j].x * rb * gg.x, vb[j].y * rb * gg.y), pk2(vb[j].z * rb * gg.z, vb[j].w * rb * gg.w)}; }
}
__device__ __forceinline__ const float* xrow_in(const Ctx& c, int r) { return r < SEQ ? c.x_prompt + (size_t)r * DM : c.x_sample + (size_t)(r - SEQ) * DM; }

__device__ __forceinline__ void phase_prologue(const Ctx& c) {
    PHASE_IDS();
    LAS float* scr = (LAS float*)(c.lds + pwave * 16384);
    const int gw = c.bid * NWAVES + pwave, NGW = c.G * NWAVES;
    tr_stream(c, scr, gw, NGW, 0, plane);
    float* tab = WSP(float, WS_TAB);
    const int gt = c.bid * NT + ptid, NGT = c.G * NT;
    for (int i = gt; i < 2048; i += NGT) { const int col = i & 1023; float v = 0.f; if (i >= 1024) { const float a0 = c.hgrn_lb[col], a1 = c.hgrn_lb[1024 + col]; v = 1.0f / (1.0f + expf(a0 - a1)); } tab[T_LB + i] = v; }
    for (int i = gt; i < (SEQ + 4) * 8; i += NGT) { const int p = i >> 3, k = i & 7; const float inv = powf(500000.0f, -(float)(2 * k) / 16.0f); const float pos = (p < SEQ) ? (float)p : (float)(PAST_LEN + (p - SEQ));
        const float ang = pos * inv; const float cs = (float)cos((double)ang), sn = (float)sin((double)ang);
        if (p < SEQ) { tab[T_COSP + i] = cs; tab[T_SINP + i] = sn; } else { tab[T_COSS + (i - SEQ * 8)] = cs; tab[T_SINS + (i - SEQ * 8)] = sn; } }
    bf16* XN = WSP(bf16, WS_XN);
    for (int r = gw; r < M + 512; r += NGW) {
        if (r < M) rms_row(xrow_in(c, r), c.norm1_g, XN + (size_t)r * DM, plane);
        else { const int l = (r - M) >> 8, s = (r - M) & 255; rms_row(c.mem_prompt + (size_t)s * DM, c.mem_norm_g + (size_t)l * DM, XN + (size_t)r * DM, plane); }
    }
}

__device__ __forceinline__ void fix_row(const float* res, const float* part, int nsplit, float* dst, int lane) {
    const f32x4* xr = (const f32x4*)res + lane; f32x4 v[8];
#pragma unroll
    for (int j = 0; j < 8; ++j) v[j] = xr[64 * j];
    for (int ks = 0; ks < nsplit; ++ks) { const f32x4* pr = (const f32x4*)(part + (size_t)ks * NS * DM) + lane;
#pragma unroll
        for (int j = 0; j < 8; ++j) v[j] += ldnt(pr + 64 * j); }
    f32x4* o = (f32x4*)dst + lane;
#pragma unroll
    for (int j = 0; j < 8; ++j) o[64 * j] = v[j];
}
__device__ __forceinline__ void phase_rmsnorm(const Ctx& c, const float* g, const float* res_s, int nsplit, bool norm) {
    PHASE_IDS();
    bf16* XN = WSP(bf16, WS_XN); const float* PART = WSP(float, WS_PART); const int gw = c.bid * NWAVES + pwave, NGW = c.G * NWAVES;
    for (int r = gw; r < NS; r += NGW) { float* row = c.out + O_Y + (size_t)(SEQ + r) * DM; fix_row(res_s + (size_t)r * DM, PART + (size_t)r * DM, nsplit, row, plane);
        if (norm) rms_row(row, g, XN + (size_t)(SEQ + r) * DM, plane); }
    if (!norm) return;
    for (int r = gw; r < SEQ; r += 2 * NGW) { const int r2 = r + NGW; rms_row2(c.out + O_Y + (size_t)r * DM, XN + (size_t)r * DM, r2 < SEQ ? c.out + O_Y + (size_t)r2 * DM : nullptr, XN + (size_t)r2 * DM, g, plane); }
}

__device__ __forceinline__ void mix_prep(const Ctx& c, int l) {
    PHASE_IDS();
    bf16* P = WSP(bf16, WS_P); const float* tab = WSP(float, WS_TAB);
    const int gw = c.bid * NWAVES + pwave, NGW = c.G * NWAVES, lane = plane, sub = lane & 7, grp = lane >> 3;
    const float* qg = c.swa_qnorm_g + l * 64; const float* kg = c.swa_knorm_g + l * 64; const float* mg = c.mem_qnorm_g + l * 256;
    for (int r = gw; r < SEQ; r += NGW) {
        const float* cs = (r < SEQ) ? tab + T_COSP + (size_t)r * 8 : tab + T_COSS + ((r - SEQ) & 3) * 8;
        const float* sn = (r < SEQ) ? tab + T_SINP + (size_t)r * 8 : tab + T_SINS + ((r - SEQ) & 3) * 8;
        v4u raw[3]; const int hm = lane >> 4, s16 = lane & 15; bf16* pmq = P + (size_t)r * INC + C_QM + hm * 256 + s16 * 8;
#pragma unroll
        for (int pass = 0; pass < 3; ++pass) raw[pass] = *(const v4u*)(P + (size_t)r * INC + C_QC + (pass * 8 + grp) * 64 + sub * 8);
        const v4u rawa = *(const v4u*)pmq, rawb = *(const v4u*)(pmq + 128);
#pragma unroll
        for (int pass = 0; pass < 3; ++pass) {
            const int hd = pass * 8 + grp;
            bf16* p = P + (size_t)r * INC + C_QC + hd * 64 + sub * 8;
            float f[8]; unpack8(raw[pass], f);
            {
                const bool nrm = hd < 20;
                float ss = 0.f;
#pragma unroll
                for (int j = 0; j < 8; ++j) ss += f[j] * f[j];
                ss += __shfl_xor(ss, 1); ss += __shfl_xor(ss, 2); ss += __shfl_xor(ss, 4);
                const float rstd = 1.0f / sqrtf(ss * (1.f / 64.f) + EPS); const float* g = (hd < 16) ? qg : kg;
                if (nrm) {
#pragma unroll
                    for (int j = 0; j < 8; ++j) f[j] = f[j] * rstd * g[sub * 8 + j]; }
                float o[8];
#pragma unroll
                for (int j = 0; j < 8; ++j) o[j] = __shfl_xor(f[j], 1);
                if (nrm && sub == 0) {
#pragma unroll
                    for (int j = 0; j < 8; ++j) f[j] = f[j] * cs[j] - o[j] * sn[j]; }
                else if (nrm && sub == 1) {
#pragma unroll
                    for (int j = 0; j < 8; ++j) f[j] = f[j] * cs[j] + o[j] * sn[j]; }
                if (hd < 16) {
#pragma unroll
                    for (int j = 0; j < 8; ++j) f[j] *= 0.125f; }
                if (nrm) *(v4u*)p = pack8(f);
            }
            if (hd >= 16) {
                const int kh = (hd - 16) & 3; const size_t ob = (hd < 20) ? O_KP : O_VP, os = (hd < 20) ? O_KS : O_VS;
                float* dst = nullptr;
                if (r < SEQ) { if (r >= SEQ - 128) dst = c.out + ob + ((size_t)l * 128 + (r - (SEQ - 128))) * 256 + kh * 64 + sub * 8; }
                else { const int b = (r - SEQ) >> 2, i = (r - SEQ) & 3; dst = c.out + os + (((size_t)l * DECB + b) * 128 + 124 + i) * 256 + kh * 64 + sub * 8; }
                if (dst) { *(f32x4*)dst = (f32x4){f[0], f[1], f[2], f[3]}; *(f32x4*)(dst + 4) = (f32x4){f[4], f[5], f[6], f[7]}; }
            }
        }
        { bf16* p = pmq; float a[8], b[8]; unpack8(rawa, a); unpack8(rawb, b);
            float ss = 0.f;
#pragma unroll
            for (int j = 0; j < 8; ++j) ss += a[j] * a[j] + b[j] * b[j];
            ss += __shfl_xor(ss, 1); ss += __shfl_xor(ss, 2); ss += __shfl_xor(ss, 4); ss += __shfl_xor(ss, 8);
            const float rstd = 0.0625f / sqrtf(ss * (1.f / 256.f) + EPS);
#pragma unroll
            for (int j = 0; j < 8; ++j) { a[j] *= rstd * mg[s16 * 8 + j]; b[j] *= rstd * mg[128 + s16 * 8 + j]; }
            *(v4u*)p = pack8(a); *(v4u*)(p + 128) = pack8(b); }
    }
}
__device__ __forceinline__ void mix_memkv(const Ctx& c) {
    PHASE_IDS();
    const float* KV = WSP(float, WS_KVRAW); bf16* KM = WSP(bf16, WS_KMEM); bf16* VT = WSP(bf16, WS_VMEMT);
    const int gw = c.bid * NWAVES + pwave, NGW = c.G * NWAVES, lane = plane;
    for (int it = gw; it < 2 * 256 * 4; it += NGW) {
        const int l = it >> 10, s = (it >> 2) & 255, hm = it & 3;
        const float* kr = KV + (size_t)s * 4096 + l * 2048 + hm * 256; const float* vr = kr + 1024;
        const f32x4 k4 = *(const f32x4*)(kr + lane * 4), v4 = *(const f32x4*)(vr + lane * 4);
        const float ss = wave_sum((k4.x * k4.x + k4.y * k4.y) + (k4.z * k4.z + k4.w * k4.w)); const float rstd = 1.0f / sqrtf(ss * (1.f / 256.f) + EPS);
        const f32x4 g4 = *(const f32x4*)(c.mem_knorm_g + l * 256 + lane * 4); const f32x4 kn = k4 * rstd * g4;
        *(f32x4*)(c.out + O_MKP + ((size_t)l * 256 + s) * 1024 + hm * 256 + lane * 4) = kn;
        *(f32x4*)(c.out + O_MVP + ((size_t)l * 256 + s) * 1024 + hm * 256 + lane * 4) = v4;
        v2u w; w.x = pk2(kn.x, kn.y); w.y = pk2(kn.z, kn.w); *(v2u*)(KM + (((size_t)l * 4 + hm) * 256 + s) * 256 + lane * 4) = w;
        bf16* vt = VT + (((size_t)l * 4 + hm) * 256 + lane * 4) * 256 + s;
        vt[0] = (bf16)f2bf(v4.x); vt[256] = (bf16)f2bf(v4.y); vt[512] = (bf16)f2bf(v4.z); vt[768] = (bf16)f2bf(v4.w);
    }
}
__device__ __forceinline__ void ld8(const bf16* p, float (&f)[8]) { unpack8(*(const v4u*)p, f); }
__device__ __forceinline__ void mix_pool(const Ctx& c, int l, bool prompt_part, bool sample_part) {
    PHASE_IDS();
    const bf16* __restrict__ P = WSP(bf16, WS_P); bf16* __restrict__ D = WSP(bf16, WS_D);
    const int tid = ptid;
    if (prompt_part && tid < 128) {
        for (int rg = c.bid; rg < SEQ / 32; rg += c.G) { const int it = rg * 128 + tid;
            const int R0 = (it >> 7) * 32, c8 = (it & 127) * 8, win = 2 << (c8 >> 8); const bf16* ub = P + C_UB + c8;
            float S[8];
#pragma unroll
            for (int j = 0; j < 8; ++j) S[j] = 0.f;
            for (int k = 1; k <= win; ++k) if (R0 - k >= 0) { float t[8]; ld8(ub + (size_t)(R0 - k) * INC, t);
#pragma unroll
                for (int j = 0; j < 8; ++j) S[j] += t[j]; }
#pragma unroll 8
            for (int i = 0; i < 32; ++i) { const int t = R0 + i; float u[8], o[8]; ld8(ub + (size_t)t * INC, u);
                if (t - win >= 0) ld8(ub + (size_t)(t - win) * INC, o); else {
#pragma unroll
                    for (int j = 0; j < 8; ++j) o[j] = 0.f; }
                const float ic = frcp((float)((t + 1 < win) ? t + 1 : win)); float d[8];
#pragma unroll
                for (int j = 0; j < 8; ++j) { S[j] += u[j] - o[j]; d[j] = S[j] * ic - u[j]; }
                *(v4u*)(D + (size_t)t * 1024 + c8) = pack8(d);
                if (t >= SEQ - 15) { float* __restrict__ op = c.out + O_PLP + ((size_t)l * 15 + (t - (SEQ - 15))) * 1024 + c8; *(f32x4*)op = (f32x4){u[0], u[1], u[2], u[3]}; *(f32x4*)(op + 4) = (f32x4){u[4], u[5], u[6], u[7]}; } }
        }
    }
    if (sample_part && tid >= 128) {
        for (int it2 = c.bid * (NT - 128) + (tid - 128); it2 < NS * 128; it2 += c.G * (NT - 128)) {
            const int r = SEQ + (it2 >> 7), c8 = (it2 & 127) * 8, win = 2 << (c8 >> 8);
            float u[8], s[8]; ld8(P + (size_t)r * INC + C_UB + c8, u);
#pragma unroll
            for (int j = 0; j < 8; ++j) s[j] = u[j];
            const int b = (r - SEQ) >> 2, i = (r - SEQ) & 3;
            for (int k = 1; k < win; ++k) { const int e = 15 + i - k; float t[8];
                if (e >= 15) ld8(P + (size_t)(r - k) * INC + C_UB + c8, t);
                else { const float* cp = c.cache_pool + (((size_t)l * DECB + b) * 15 + e) * 1024 + c8; const f32x4 a = *(const f32x4*)cp, bb = *(const f32x4*)(cp + 4); t[0] = a.x; t[1] = a.y; t[2] = a.z; t[3] = a.w; t[4] = bb.x; t[5] = bb.y; t[6] = bb.z; t[7] = bb.w; }
#pragma unroll
                for (int j = 0; j < 8; ++j) s[j] += t[j]; }
            const float ic = 1.0f / (float)win; float d[8];
#pragma unroll
            for (int j = 0; j < 8; ++j) d[j] = s[j] * ic - u[j];
            *(v4u*)(D + (size_t)r * 1024 + c8) = pack8(d);
            float* ob = c.out + O_PLS + ((size_t)l * DECB + b) * 15 * 1024 + c8;
            *(f32x4*)(ob + (size_t)(11 + i) * 1024) = (f32x4){u[0], u[1], u[2], u[3]}; *(f32x4*)(ob + (size_t)(11 + i) * 1024 + 4) = (f32x4){u[4], u[5], u[6], u[7]};
            for (int j = i; j < 11; j += 4) { const float* cp = c.cache_pool + (((size_t)l * DECB + b) * 15 + j + 4) * 1024 + c8; *(f32x4*)(ob + (size_t)j * 1024) = *(const f32x4*)cp; *(f32x4*)(ob + (size_t)j * 1024 + 4) = *(const f32x4*)(cp + 4); }
        }
    }
}
#define MFMA16(a, b, cc) __builtin_amdgcn_mfma_f32_16x16x32_bf16((a), (b), (cc), 0, 0, 0)
__device__ __forceinline__ void mix_hgrn_local(const Ctx& c, int l) {
    PHASE_IDS();
    bf16* P = WSP(bf16, WS_P); const float* LOGF = WSP(float, WS_LOGF); float* OLOC = WSP(float, WS_OLOC); float* U = WSP(float, WS_U); float* DTOT = WSP(float, WS_DTOT);
    LAS bf16* QT = (LAS bf16*)(c.lds); LAS bf16* KT = (LAS bf16*)(c.lds + 8704); LAS bf16* KTT = (LAS bf16*)(c.lds + 17408); LAS bf16* VT = (LAS bf16*)(c.lds + 27648);
    LAS bf16* SLT = (LAS bf16*)(c.lds + 37888); LAS float* EBL = (LAS float*)(c.lds + 72704); LAS float* PART = (LAS float*)(c.lds + 73216);
    const int tid = ptid, lane = plane, w = pwave, d = tid & 127, tq = tid >> 7, lr = lane & 15, g = lane >> 4;
    float lf[8], lfn[8]; unsigned qr[8], qrn[8], vr[8], vrn[8];
#define HL_LOAD(LF, QR, VR, UNIT, CH) do { const int _h = (UNIT) & 7, _t0 = ((UNIT) >> 3) * SCT + 32 * (CH) + 8 * tq; _Pragma("unroll") for (int j = 0; j < 8; ++j) { \
        LF[j] = ldnt(LOGF + (size_t)(_t0 + j) * 1024 + _h * 128 + d); QR[j] = P[(size_t)(_t0 + j) * INC + C_QA + _h * 128 + d]; VR[j] = P[(size_t)(_t0 + j) * INC + C_IA + _h * 128 + d]; } } while (0)
    int unit = c.bid, ch = 0; bool have = unit < 8 * NSC;
    if (have) HL_LOAD(lf, qr, vr, unit, ch);
    f32x4 Sl[8]; float Bprev = 0.f;
#pragma unroll 1
    while (have) {
        const int h = unit & 7, sc = unit >> 3, T0 = sc * SCT;
        if (ch == 0) { Bprev = 0.f;
#pragma unroll
            for (int db = 0; db < 8; ++db) { Sl[db] = (f32x4){0.f, 0.f, 0.f, 0.f}; *(LAS v2u*)(SLT + (16 * w + lr) * 136 + 16 * db + 4 * g) = (v2u){0u, 0u}; } }
        {
            const int t0 = T0 + 32 * ch + 8 * tq;
            float pb[8]; float run = 0.f;
#pragma unroll
            for (int j = 0; j < 8; ++j) { run += lf[j]; pb[j] = run; }
            PART[tq * 128 + d] = run;
            __syncthreads();
            float off = 0.f, bl = 0.f;
#pragma unroll
            for (int q = 0; q < 4; ++q) { const float pq = PART[q * 128 + d]; if (q < tq) off += pq; bl += pq; }
            unsigned ktp[4], vtp[4];
#pragma unroll
            for (int j = 0; j < 8; ++j) {
                const float b = off + pb[j]; bf16* qp = P + (size_t)(t0 + j) * INC + C_QA + h * 128 + d;
                const float q = bf2f(qr[j]); const unsigned vb = vr[j];
                const float eb = __expf(b), einv = __expf(fminf(-b, 80.f)), kk = 1.0f - __expf(lf[j]);
                const float qt = q * eb, kt = kk * einv; const unsigned qtb = f2bf(qt), ktb = f2bf(kt);
                QT[(8 * tq + j) * 136 + d] = (bf16)qtb; KT[(8 * tq + j) * 136 + d] = (bf16)ktb;
                if (j & 1) { ktp[j >> 1] |= ktb << 16; vtp[j >> 1] |= vb << 16; } else { ktp[j >> 1] = ktb; vtp[j >> 1] = vb; }
                *qp = (bf16)f2bf(qt * __expf(Bprev));
            }
            *(LAS v4u*)(KTT + d * 40 + 8 * tq) = (v4u){ktp[0], ktp[1], ktp[2], ktp[3]};
            *(LAS v4u*)(VT + d * 40 + 8 * tq) = (v4u){vtp[0], vtp[1], vtp[2], vtp[3]};
            if (tq == 0) EBL[d] = __expf(bl);
            Bprev += bl;
            __syncthreads();
            int nunit = unit, nch = ch + 1; if (nch == NCH) { nch = 0; nunit += c.G; }
            const bool nhave = nunit < 8 * NSC;
            if (nhave) HL_LOAD(lfn, qrn, vrn, nunit, nch);
            bf16x8 qf[2][4];
#pragma unroll
            for (int tb = 0; tb < 2; ++tb)
#pragma unroll
                for (int ks = 0; ks < 4; ++ks) qf[tb][ks] = *(const LAS bf16x8*)(QT + (16 * tb + lr) * 136 + 32 * ks + 8 * g);
            f32x4 st[2][2];
#pragma unroll
            for (int sb = 0; sb < 2; ++sb)
#pragma unroll
                for (int tb = 0; tb < 2; ++tb) { f32x4 a = (f32x4){0.f, 0.f, 0.f, 0.f};
#pragma unroll
                    for (int ks = 0; ks < 4; ++ks) a = MFMA16(*(const LAS bf16x8*)(KT + (16 * sb + lr) * 136 + 32 * ks + 8 * g), qf[tb][ks], a);
#pragma unroll
                    for (int j = 0; j < 4; ++j) if (16 * sb + 4 * g + j > 16 * tb + lr) a[j] = 0.f;
                    st[sb][tb] = a; }
            const v2u vlo = *(const LAS v2u*)(VT + (16 * w + lr) * 40 + 4 * g), vhi = *(const LAS v2u*)(VT + (16 * w + lr) * 40 + 16 + 4 * g);
            const bf16x8 vperm = __builtin_bit_cast(bf16x8, (v4u){vlo.x, vlo.y, vhi.x, vhi.y});
#pragma unroll
            for (int tb = 0; tb < 2; ++tb) {
                f32x4 o = (f32x4){0.f, 0.f, 0.f, 0.f};
#pragma unroll
                for (int ks = 0; ks < 4; ++ks) o = MFMA16(*(const LAS bf16x8*)(SLT + (16 * w + lr) * 136 + 32 * ks + 8 * g), qf[tb][ks], o);
                const bf16x8 pf = __builtin_bit_cast(bf16x8, (v4u){pk2(st[0][tb][0], st[0][tb][1]), pk2(st[0][tb][2], st[0][tb][3]), pk2(st[1][tb][0], st[1][tb][1]), pk2(st[1][tb][2], st[1][tb][3])});
                o = MFMA16(vperm, pf, o);
                *(f32x4*)(OLOC + (size_t)(T0 + 32 * ch + 16 * tb + lr) * 1024 + h * 128 + 16 * w + 4 * g) = o;
            }
            const bf16x8 vnat = *(const LAS bf16x8*)(VT + (16 * w + lr) * 40 + 8 * g);
#pragma unroll
            for (int db = 0; db < 8; ++db) {
                Sl[db] = MFMA16(*(const LAS bf16x8*)(KTT + (16 * db + lr) * 40 + 8 * g), vnat, Sl[db]);
                const f32x4 e4 = *(const LAS f32x4*)(EBL + 16 * db + 4 * g); Sl[db] = Sl[db] * e4;
                *(LAS v2u*)(SLT + (16 * w + lr) * 136 + 16 * db + 4 * g) = (v2u){pk2(Sl[db][0], Sl[db][1]), pk2(Sl[db][2], Sl[db][3])};
            }
            if (ch == NCH - 1) {
#pragma unroll
                for (int db = 0; db < 8; ++db) *(f32x4*)(U + ((size_t)(sc * 8 + h) * 16384) + ((w * 8 + db) * 64 + lane) * 4) = Sl[db];
                if (tq == 0) DTOT[(size_t)(sc * 8 + h) * 128 + d] = __expf(Bprev); }
            __syncthreads();
#pragma unroll
            for (int j = 0; j < 8; ++j) { lf[j] = lfn[j]; qr[j] = qrn[j]; vr[j] = vrn[j]; }
            unit = nunit; ch = nch; have = nhave;
        }
    }
#undef HL_LOAD
}
__device__ __forceinline__ void mix_hgrn_sample(const Ctx& c, int l) {
    PHASE_IDS();
    const bf16* P = WSP(bf16, WS_P); const float* LOGF = WSP(float, WS_LOGF); bf16* Y = WSP(bf16, WS_Y);
    LAS float* QF = (LAS float*)(c.lds); LAS float* FF = QF + 512; LAS float* KF = FF + 512; LAS float* VF = KF + 512; LAS float* RED = VF + 512; LAS float* SS = RED + 4 * 16 * 128;
    const int tid = ptid, dg = tid >> 5, d0 = dg * 8, e0 = (tid & 31) * 4;
    f32x4 S[8], Sn[8];
    if (c.bid < DECB * 8) { const float* sp0 = c.state_hgrn + ((size_t)l * DECB * 8 + c.bid) * 16384;
#pragma unroll
        for (int j = 0; j < 8; ++j) S[j] = ldnt((const f32x4*)(sp0 + (size_t)(d0 + j) * 128 + e0)); }
    for (int unit = c.bid; unit < DECB * 8; unit += c.G) {
        const int b = unit >> 3, h = unit & 7; const int r0 = SEQ + 4 * b;
        { const int i = tid >> 7, dd = tid & 127; const size_t rb = (size_t)(r0 + i) * INC + h * 128 + dd;
            QF[tid] = bf2f(P[rb + C_QA]); const float f = __expf(LOGF[(size_t)(r0 + i) * 1024 + h * 128 + dd]); FF[tid] = f; KF[tid] = 1.0f - f; VF[tid] = bf2f(P[rb + C_IA]); }
        __syncthreads();
        if (unit + c.G < DECB * 8) { const float* spn = c.state_hgrn + ((size_t)l * DECB * 8 + unit + c.G) * 16384;
#pragma unroll
            for (int j = 0; j < 8; ++j) Sn[j] = ldnt((const f32x4*)(spn + (size_t)(d0 + j) * 128 + e0)); }
#pragma unroll
        for (int i = 0; i < 4; ++i) { const f32x4 v4 = *(const LAS f32x4*)(VF + i * 128 + e0); f32x4 part = (f32x4){0.f, 0.f, 0.f, 0.f};
#pragma unroll
            for (int j = 0; j < 8; ++j) { const float f = FF[i * 128 + d0 + j], k = KF[i * 128 + d0 + j], q = QF[i * 128 + d0 + j]; S[j] = S[j] * f + v4 * k; part += S[j] * q; }
            *(LAS f32x4*)(RED + (i * 16 + dg) * 128 + e0) = part; }
        float* so = c.out + O_HSS + (((size_t)l * DECB + b) * 8 + h) * 16384;
#pragma unroll
        for (int j = 0; j < 8; ++j) stnt((f32x4*)(so + (size_t)(d0 + j) * 128 + e0), S[j]);
        __syncthreads();
        { const int i = tid >> 7, e = tid & 127; float o = 0.f;
#pragma unroll
            for (int q = 0; q < 16; ++q) o += RED[(i * 16 + q) * 128 + e];
            const float ss = wave_sum(o * o); if (plane == 0) SS[pwave] = ss;
            __syncthreads();
            const float tot = SS[2 * i] + SS[2 * i + 1]; const float rstd = 1.0f / sqrtf(tot * (1.f / 128.f) + EPS);
            const float ga = bf2f(P[(size_t)(r0 + i) * INC + C_GA + h * 128 + e]);
            Y[(size_t)(r0 + i) * 4096 + h * 128 + e] = (bf16)f2bf(o * rstd * c.hgrn_norm_g[l * 1024 + h * 128 + e] * ga); }
        __syncthreads();
#pragma unroll
        for (int j = 0; j < 8; ++j) S[j] = Sn[j];
    }
}

__device__ __forceinline__ void mix_hgrn_scan(const Ctx& c, int l) {
    PHASE_IDS();
    const float* U = WSP(float, WS_U); const float* DTOT = WSP(float, WS_DTOT); bf16* SIN = WSP(bf16, WS_SIN);
    const int gt = c.bid * NT + ptid, NGT = c.G * NT;
    constexpr int UB = (NSC % 16 == 0) ? 16 : (NSC % 4 == 0) ? 4 : (NSC % 2 == 0) ? 2 : 1; static_assert(NSC % UB == 0, "scan batch");
    for (int it = gt; it < 8 * 16384; it += NGT) {
        const int h = it >> 14, idx = it & 16383, j = idx & 3, ln = (idx >> 2) & 63, db = (idx >> 8) & 7, w = idx >> 11, dd = 16 * db + 4 * (ln >> 4) + j, e = 16 * w + (ln & 15);
        float S = 0.f;
        for (int sc0 = 0; sc0 < NSC; sc0 += UB) { float u[UB], dv[UB];
#pragma unroll
            for (int k = 0; k < UB; ++k) { u[k] = ldnt(U + (size_t)((sc0 + k) * 8 + h) * 16384 + idx); dv[k] = DTOT[(size_t)((sc0 + k) * 8 + h) * 128 + dd]; }
#pragma unroll
            for (int k = 0; k < UB; ++k) { SIN[(size_t)((sc0 + k) * 8 + h) * 16384 + idx] = (bf16)f2bf(S); S = S * dv[k] + u[k]; } }
        c.out[O_HSP + ((size_t)l * 8 + h) * 16384 + (size_t)dd * 128 + e] = S;
    }
}
__device__ __forceinline__ void mix_swa_prompt(const Ctx& c, int l) {
    PHASE_IDS();
    const bf16* P = WSP(bf16, WS_P); bf16* Y = WSP(bf16, WS_Y);
    LAS bf16* KI = (LAS bf16*)(c.lds); LAS bf16* VTI = (LAS bf16*)(c.lds + 192 * 72 * 2);
    const int tid = ptid, lane = plane, w = pwave, lr = lane & 15, g = lane >> 4;
    for (int unit = c.bid; unit < 4 * (SEQ / 64); unit += c.G) {
        const int kh = unit & 3, qb = unit >> 2, s0 = 64 * qb - 128;
        for (int it = tid; it < 192 * 8; it += NT) { const int s = it >> 3, ck = it & 7, sa = s0 + s; v4u kv = (v4u){0u, 0u, 0u, 0u}, vv = kv;
            if (sa >= 0) { kv = *(const v4u*)(P + (size_t)sa * INC + C_KC + kh * 64 + ck * 8); vv = *(const v4u*)(P + (size_t)sa * INC + C_VC + kh * 64 + ck * 8); }
            *(LAS v4u*)(KI + s * 72 + ck * 8) = kv;
            LAS bf16* vt = VTI + (ck * 8) * 200 + s;
            vt[0] = (bf16)(vv.x & 0xffff); vt[200] = (bf16)(vv.x >> 16); vt[400] = (bf16)(vv.y & 0xffff); vt[600] = (bf16)(vv.y >> 16);
            vt[800] = (bf16)(vv.z & 0xffff); vt[1000] = (bf16)(vv.z >> 16); vt[1200] = (bf16)(vv.w & 0xffff); vt[1400] = (bf16)(vv.w >> 16); }
        __syncthreads();
        const int hq = 4 * kh + (w >> 1), tq0 = 64 * qb + 32 * (w & 1);
        bf16x8 qf[2][2];
#pragma unroll
        for (int tb = 0; tb < 2; ++tb)
#pragma unroll
            for (int ks = 0; ks < 2; ++ks) qf[tb][ks] = *(const bf16x8*)(P + (size_t)(tq0 + 16 * tb + lr) * INC + C_QC + hq * 64 + 32 * ks + 8 * g);
        const float sink = c.swa_sinks[l * 16 + hq];
        f32x4 st[2][12];
#pragma unroll
        for (int sb = 0; sb < 12; ++sb) {
            const bf16x8 k0 = *(const LAS bf16x8*)(KI + (16 * sb + lr) * 72 + 8 * g), k1 = *(const LAS bf16x8*)(KI + (16 * sb + lr) * 72 + 32 + 8 * g);
#pragma unroll
            for (int tb = 0; tb < 2; ++tb) { f32x4 a = MFMA16(k0, qf[tb][0], ((f32x4){0.f, 0.f, 0.f, 0.f})); a = MFMA16(k1, qf[tb][1], a); st[tb][sb] = a; } }
        float inv[2];
#pragma unroll
        for (int tb = 0; tb < 2; ++tb) {
            const int ta = tq0 + 16 * tb + lr; float mx = sink;
#pragma unroll
            for (int sb = 0; sb < 12; ++sb)
#pragma unroll
                for (int j = 0; j < 4; ++j) { const int sa = s0 + 16 * sb + 4 * g + j; const bool ok = sa >= 0 && sa <= ta && ta - sa < 128; const float v = ok ? st[tb][sb][j] : -1e30f; st[tb][sb][j] = v; mx = fmaxf(mx, v); }
            mx = fmaxf(mx, __shfl_xor(mx, 16)); mx = fmaxf(mx, __shfl_xor(mx, 32));
            float sum = 0.f;
#pragma unroll
            for (int sb = 0; sb < 12; ++sb)
#pragma unroll
                for (int j = 0; j < 4; ++j) { const float p = __expf(st[tb][sb][j] - mx); st[tb][sb][j] = p; sum += p; }
            sum += __shfl_xor(sum, 16); sum += __shfl_xor(sum, 32);
            inv[tb] = 1.0f / (sum + __expf(sink - mx));
        }
        f32x4 o[2][4];
#pragma unroll
        for (int tb = 0; tb < 2; ++tb)
#pragma unroll
            for (int eb = 0; eb < 4; ++eb) o[tb][eb] = (f32x4){0.f, 0.f, 0.f, 0.f};
#pragma unroll
        for (int kk = 0; kk < 6; ++kk) {
            bf16x8 pf[2];
#pragma unroll
            for (int tb = 0; tb < 2; ++tb) pf[tb] = __builtin_bit_cast(bf16x8, (v4u){pk2(st[tb][2 * kk][0], st[tb][2 * kk][1]), pk2(st[tb][2 * kk][2], st[tb][2 * kk][3]), pk2(st[tb][2 * kk + 1][0], st[tb][2 * kk + 1][1]), pk2(st[tb][2 * kk + 1][2], st[tb][2 * kk + 1][3])});
#pragma unroll
            for (int eb = 0; eb < 4; ++eb) { const v2u vlo = *(const LAS v2u*)(VTI + (16 * eb + lr) * 200 + 32 * kk + 4 * g), vhi = *(const LAS v2u*)(VTI + (16 * eb + lr) * 200 + 32 * kk + 16 + 4 * g);
                const bf16x8 vf = __builtin_bit_cast(bf16x8, (v4u){vlo.x, vlo.y, vhi.x, vhi.y});
#pragma unroll
                for (int tb = 0; tb < 2; ++tb) o[tb][eb] = MFMA16(vf, pf[tb], o[tb][eb]); } }
#pragma unroll
        for (int tb = 0; tb < 2; ++tb)
#pragma unroll
            for (int eb = 0; eb < 4; ++eb) { const f32x4 v = o[tb][eb] * inv[tb]; *(v2u*)(Y + (size_t)(tq0 + 16 * tb + lr) * 4096 + 2048 + hq * 64 + 16 * eb + 4 * g) = (v2u){pk2(v[0], v[1]), pk2(v[2], v[3])}; }
        __syncthreads();
    }
}
__device__ __forceinline__ void mix_swa_sample(const Ctx& c, int l) {
    PHASE_IDS();
    const bf16* P = WSP(bf16, WS_P); bf16* Y = WSP(bf16, WS_Y);
    LAS float* KF = (LAS float*)(c.lds); LAS float* VF = KF + 132 * 68; LAS float* SC = VF + 132 * 64; LAS float* DEN = SC + 16 * 136; LAS float* QS = DEN + 16;
    const int tid = ptid;
    for (int unit = c.bid; unit < DECB * 4; unit += c.G) {
        const int b = unit >> 2, kh = unit & 3, r0 = SEQ + 4 * b;
        const float* kc = c.cache_swa_k + ((size_t)l * DECB + b) * 128 * 256 + kh * 64; const float* vc = c.cache_swa_v + ((size_t)l * DECB + b) * 128 * 256 + kh * 64;
        float* ko = c.out + O_KS + ((size_t)l * DECB + b) * 128 * 256 + kh * 64; float* vo = c.out + O_VS + ((size_t)l * DECB + b) * 128 * 256 + kh * 64;
        { f32x4 k4[4], v4[4];
#pragma unroll
            for (int rep = 0; rep < 4; ++rep) { const int it = tid + rep * NT, s = it >> 4, q4 = (it & 15) * 4; k4[rep] = ldnt((const f32x4*)(kc + (size_t)s * 256 + q4)); v4[rep] = ldnt((const f32x4*)(vc + (size_t)s * 256 + q4)); }
#pragma unroll
            for (int rep = 0; rep < 4; ++rep) { const int it = tid + rep * NT, s = it >> 4, q4 = (it & 15) * 4;
                *(LAS f32x4*)(KF + s * 68 + q4) = k4[rep]; *(LAS f32x4*)(VF + s * 64 + q4) = v4[rep];
                if (s >= 4) { stnt((f32x4*)(ko + (size_t)(s - 4) * 256 + q4), k4[rep]); stnt((f32x4*)(vo + (size_t)(s - 4) * 256 + q4), v4[rep]); } } }
        { const float* tab = WSP(float, WS_TAB);
          const int i = tid >> 6, dd = tid & 63;
          if (tid < 256) {
            float kv = bf2f(P[(size_t)(r0 + i) * INC + C_KC + kh * 64 + dd]); const float vv = bf2f(P[(size_t)(r0 + i) * INC + C_VC + kh * 64 + dd]);
            const float ssq = wave_sum(kv * kv); kv = kv * (1.0f / sqrtf(ssq * (1.f / 64.f) + EPS)) * c.swa_knorm_g[l * 64 + dd];
            const float other = __shfl_xor(kv, 8);
            if (dd < 16) { const float cs = tab[T_COSS + i * 8 + (dd & 7)], sn = tab[T_SINS + i * 8 + (dd & 7)]; kv = (dd < 8) ? kv * cs - other * sn : kv * cs + other * sn; }
            KF[(128 + i) * 68 + dd] = kv; VF[(128 + i) * 64 + dd] = vv;
            ko[(size_t)(124 + i) * 256 + dd] = kv; vo[(size_t)(124 + i) * 256 + dd] = vv; } }
        { const float* tab = WSP(float, WS_TAB);
#pragma unroll
          for (int rr = 0; rr < 2; ++rr) { const int qrow = 2 * pwave + rr, qi = qrow >> 2, qh = qrow & 3;
            float qv = bf2f(P[(size_t)(r0 + qi) * INC + C_QC + (4 * kh + qh) * 64 + plane]);
            const float ssq = wave_sum(qv * qv); qv = qv * (0.125f / sqrtf(ssq * (1.f / 64.f) + EPS)) * c.swa_qnorm_g[l * 64 + plane];
            const float other = __shfl_xor(qv, 8);
            if (plane < 16) { const float cs = tab[T_COSS + qi * 8 + (plane & 7)], sn = tab[T_SINS + qi * 8 + (plane & 7)]; qv = (plane < 8) ? qv * cs - other * sn : qv * cs + other * sn; }
            QS[qrow * 64 + plane] = qv; } }
        const int row = tid >> 5, ks = tid & 31, ti = row >> 2, hl = row & 3;
        __syncthreads();
        float q[64];
#pragma unroll
        for (int j = 0; j < 16; ++j) { const f32x4 t4 = *(const LAS f32x4*)(QS + row * 64 + 4 * j); q[4 * j] = t4.x; q[4 * j + 1] = t4.y; q[4 * j + 2] = t4.z; q[4 * j + 3] = t4.w; }
        { const float sink = c.swa_sinks[l * 16 + 4 * kh + hl]; float mx = sink;
            for (int ci = ks; ci < 132; ci += 32) { float s0 = 0.f, s1 = 0.f;
#pragma unroll
                for (int j = 0; j < 16; ++j) { const f32x4 k4 = *(const LAS f32x4*)(KF + ci * 68 + 4 * j); s0 += q[4 * j] * k4.x + q[4 * j + 1] * k4.y; s1 += q[4 * j + 2] * k4.z + q[4 * j + 3] * k4.w; }
                float sv = s0 + s1; const bool ok = ci > ti && ci <= ti + 128; sv = ok ? sv : -1e30f; SC[row * 136 + ci] = sv; mx = fmaxf(mx, sv); }
#pragma unroll
            for (int o = 1; o < 32; o <<= 1) mx = fmaxf(mx, __shfl_xor(mx, o));
            float sum = 0.f;
            for (int ci = ks; ci < 132; ci += 32) { const float p = __expf(SC[row * 136 + ci] - mx); SC[row * 136 + ci] = p; sum += p; }
#pragma unroll
            for (int o = 1; o < 32; o <<= 1) sum += __shfl_xor(sum, o);
            if (ks == 0) DEN[row] = frcp(sum + __expf(sink - mx)); }
        __syncthreads();
        { const int e4 = (tid & 15) * 4, half = (tid >> 4) & 1; f32x4 o = (f32x4){0.f, 0.f, 0.f, 0.f};
#pragma unroll 6
            for (int j = 0; j < 66; ++j) { const int ci = half * 66 + j; o += *(const LAS f32x4*)(VF + ci * 64 + e4) * SC[row * 136 + ci]; }
            o[0] += __shfl_xor(o[0], 16); o[1] += __shfl_xor(o[1], 16); o[2] += __shfl_xor(o[2], 16); o[3] += __shfl_xor(o[3], 16);
            if (half == 0) { const float inv = DEN[row]; *(v2u*)(Y + (size_t)(r0 + ti) * 4096 + 2048 + (4 * kh + hl) * 64 + e4) = (v2u){pk2(o[0] * inv, o[1] * inv), pk2(o[2] * inv, o[3] * inv)}; } }
        __syncthreads();
    }
}
__device__ __forceinline__ void mix_mem_sample(const Ctx& c, int l) {
    PHASE_IDS();
    const bf16* P = WSP(bf16, WS_P); bf16* Y = WSP(bf16, WS_Y);
    LAS float* QF = (LAS float*)(c.lds); LAS float* SC = QF + 1024; LAS float* DEN = SC + 1024; LAS float* PART = DEN + 8;
    const int tid = ptid, lane = plane, w = pwave, g = lane >> 4, l16 = lane & 15;
    for (int unit = c.bid; unit < DECB * 4; unit += c.G) {
        const int b = unit >> 2, hm = unit & 3, r0 = SEQ + 4 * b;
        const float* kb = c.cache_mem_k + ((size_t)l * DECB + b) * 256 * 1024 + hm * 256; const float* vb = c.cache_mem_v + ((size_t)l * DECB + b) * 256 * 1024 + hm * 256;
        f32x4 kk[8][4];
#pragma unroll
        for (int it = 0; it < 8; ++it)
#pragma unroll
            for (int cc = 0; cc < 4; ++cc) kk[it][cc] = ldnt((const f32x4*)(kb + (size_t)(32 * w + 4 * it + g) * 1024 + 4 * l16 + 64 * cc));
        if (w < 4) { const bf16* qp = P + (size_t)(r0 + w) * INC + C_QM + hm * 256 + 4 * lane; const v2u raw = *(const v2u*)qp;
            f32x4 q4v = (f32x4){bflo(raw.x), bfhi(raw.x), bflo(raw.y), bfhi(raw.y)}; const float ssq = wave_sum((q4v.x * q4v.x + q4v.y * q4v.y) + (q4v.z * q4v.z + q4v.w * q4v.w));
            const float rstd = 0.0625f / sqrtf(ssq * (1.f / 256.f) + EPS); const f32x4 g4 = *(const f32x4*)(c.mem_qnorm_g + l * 256 + 4 * lane);
            *(LAS f32x4*)(QF + w * 256 + 4 * lane) = q4v * rstd * g4; }
        __syncthreads();
        f32x4 vpre[16];
#pragma unroll
        for (int it = 0; it < 8; ++it) { const int s = 32 * w + 4 * it + g;
            if (it == 4) {
#pragma unroll
                for (int j = 0; j < 8; ++j) vpre[j] = ldnt((const f32x4*)(vb + (size_t)(32 * w + j) * 1024 + 4 * lane)); }
            float d[4]; int qz = 0; OPQ_S(qz);
#pragma unroll
            for (int i = 0; i < 4; ++i) { f32x4 a = (f32x4){0.f, 0.f, 0.f, 0.f};
#pragma unroll
                for (int cc = 0; cc < 4; ++cc) a += *(const LAS f32x4*)(QF + qz + i * 256 + 64 * cc + 4 * l16) * kk[it][cc];
                d[i] = (a.x + a.y) + (a.z + a.w); }
#pragma unroll
            for (int o = 1; o < 16; o <<= 1) {
#pragma unroll
                for (int i = 0; i < 4; ++i) d[i] += __shfl_xor(d[i], o); }
            if (l16 < 4) SC[l16 * 256 + s] = (l16 == 0) ? d[0] : (l16 == 1) ? d[1] : (l16 == 2) ? d[2] : d[3]; }
#pragma unroll
        for (int j = 8; j < 16; ++j) vpre[j] = ldnt((const f32x4*)(vb + (size_t)(32 * w + j) * 1024 + 4 * lane));
        __syncthreads();
        if (w < 4) { const f32x4 s4 = *(const LAS f32x4*)(SC + w * 256 + 4 * lane); float mx = fmaxf(fmaxf(s4.x, s4.y), fmaxf(s4.z, s4.w));
#pragma unroll
            for (int o = 1; o < 64; o <<= 1) mx = fmaxf(mx, __shfl_xor(mx, o));
            f32x4 p4; p4.x = __expf(s4.x - mx); p4.y = __expf(s4.y - mx); p4.z = __expf(s4.z - mx); p4.w = __expf(s4.w - mx);
            const float sum = wave_sum((p4.x + p4.y) + (p4.z + p4.w)); *(LAS f32x4*)(SC + w * 256 + 4 * lane) = p4; if (lane == 0) DEN[w] = 1.0f / sum; }
        f32x4 vlast[16];
#pragma unroll
        for (int j = 0; j < 16; ++j) vlast[j] = ldnt((const f32x4*)(vb + (size_t)(32 * w + 16 + j) * 1024 + 4 * lane));
        __syncthreads();
        f32x4 acc[4];
#pragma unroll
        for (int i = 0; i < 4; ++i) acc[i] = (f32x4){0.f, 0.f, 0.f, 0.f};
#pragma unroll
        for (int it = 0; it < 16; ++it) { const int s = 32 * w + it;
#pragma unroll
            for (int i = 0; i < 4; ++i) acc[i] += vpre[it] * SC[i * 256 + s]; }
#pragma unroll
        for (int it = 0; it < 16; ++it) { const int s = 32 * w + 16 + it;
#pragma unroll
            for (int i = 0; i < 4; ++i) acc[i] += vlast[it] * SC[i * 256 + s]; }
#pragma unroll
        for (int i = 0; i < 4; ++i) *(LAS f32x4*)(PART + (w * 4 + i) * 256 + 4 * lane) = acc[i];
        __syncthreads();
        for (int it = tid; it < 1024; it += NT) { const int i = it >> 8, e = it & 255; float o = 0.f;
#pragma unroll
            for (int q = 0; q < 8; ++q) o += PART[(q * 4 + i) * 256 + e];
            Y[(size_t)(r0 + i) * 4096 + 3072 + hm * 256 + e] = (bf16)f2bf(o * DEN[i]); }
        __syncthreads();
    }
}

__device__ __forceinline__ void mix_hgrn_final(const Ctx& c, int l) {
    PHASE_IDS();
    const bf16* P = WSP(bf16, WS_P); const float* OLOC = WSP(float, WS_OLOC); const bf16* SIN = WSP(bf16, WS_SIN); bf16* Y = WSP(bf16, WS_Y);
    LAS bf16* SI = (LAS bf16*)(c.lds);
    const int tid = ptid, lane = plane, w = pwave, lr = lane & 15, g = lane >> 4;
    for (int unit = c.bid; unit < 8 * NSC; unit += c.G) {
        const int h = unit & 7, sc = unit >> 3;
        { v4u sv[4];
#pragma unroll
          for (int k = 0; k < 4; ++k) sv[k] = ldnt((const v4u*)(SIN + (size_t)(sc * 8 + h) * 16384 + (tid + k * NT) * 8));
#pragma unroll
          for (int k = 0; k < 4; ++k) *(LAS v4u*)(SI + (tid + k * NT) * 8) = sv[k]; }
        bf16x8 qf[4]; f32x4 o[8];
#pragma unroll 1
        for (int ps = 0; ps < SCT / 128; ++ps) {
            const int t = sc * SCT + 128 * ps + 16 * w + lr;
#pragma unroll
            for (int ks = 0; ks < 4; ++ks) qf[ks] = *(const bf16x8*)(P + (size_t)t * INC + C_QA + h * 128 + 32 * ks + 8 * g);
#pragma unroll
            for (int eb = 0; eb < 8; ++eb) o[eb] = ldnt((const f32x4*)(OLOC + (size_t)t * 1024 + h * 128 + 16 * eb + 4 * g));
            if (ps == 0) __syncthreads();
            float ss = 0.f;
#pragma unroll
            for (int eb = 0; eb < 8; ++eb) { f32x4 a = o[eb];
#pragma unroll
                for (int ks = 0; ks < 4; ++ks) { const int idx = ((eb * 8 + 2 * ks + (g >> 1)) * 64 + (2 * (g & 1)) * 16 + lr) * 4;
                    const v2u lo = *(const LAS v2u*)(SI + idx), hi = *(const LAS v2u*)(SI + idx + 64);
                    a = MFMA16(__builtin_bit_cast(bf16x8, (v4u){lo.x, lo.y, hi.x, hi.y}), qf[ks], a); }
                o[eb] = a; ss += (a[0] * a[0] + a[1] * a[1]) + (a[2] * a[2] + a[3] * a[3]); }
            ss += __shfl_xor(ss, 16); ss += __shfl_xor(ss, 32);
            const float rstd = 1.0f / sqrtf(ss * (1.f / 128.f) + EPS);
#pragma unroll
            for (int eb = 0; eb < 8; ++eb) { const int e = h * 128 + 16 * eb + 4 * g; const f32x4 g4 = *(const f32x4*)(c.hgrn_norm_g + l * 1024 + e); const v2u gw = *(const v2u*)(P + (size_t)t * INC + C_GA + e);
                const f32x4 v = o[eb] * rstd * g4; *(v2u*)(Y + (size_t)t * 4096 + e) = (v2u){pk2(v[0] * bflo(gw.x), v[1] * bfhi(gw.x)), pk2(v[2] * bflo(gw.y), v[3] * bfhi(gw.y))}; }
        }
        __syncthreads();
    }
}

__device__ __forceinline__ void ldf8(const float* p, float (&f)[8]) { const f32x4 a = *(const f32x4*)p, b = *(const f32x4*)(p + 4); f[0] = a.x; f[1] = a.y; f[2] = a.z; f[3] = a.w; f[4] = b.x; f[5] = b.y; f[6] = b.z; f[7] = b.w; }
struct ConvItem { v4u a[6], v[4]; f32x4 s[4]; int r0, c8; bool smp, ok; };
__device__ __forceinline__ void conv_load(ConvItem& I, int it, int nitems, const bf16* AV, const float* state_conv, int l) {
    I.ok = it < nitems; const int it2 = I.ok ? it : 0; const int rg = it2 / (DFF / 8); I.c8 = (it2 % (DFF / 8)) * 8; I.r0 = 4 * rg; I.smp = I.r0 >= SEQ;
#pragma unroll
    for (int i = 0; i < 4; ++i) { I.a[2 + i] = (i < 2) ? ldnt((const v4u*)(AV + (size_t)(I.r0 + i) * 2 * DFF + I.c8)) : *(const v4u*)(AV + (size_t)(I.r0 + i) * 2 * DFF + I.c8); I.v[i] = ldnt((const v4u*)(AV + (size_t)(I.r0 + i) * 2 * DFF + DFF + I.c8)); }
    I.a[0] = (v4u){0u, 0u, 0u, 0u}; I.a[1] = I.a[0];
#pragma unroll
    for (int i = 0; i < 4; ++i) I.s[i] = (f32x4){0.f, 0.f, 0.f, 0.f};
    if (I.smp) { const float* sp = state_conv + ((size_t)l * DECB + (I.r0 - SEQ) / 4) * 2 * DFF + I.c8; I.s[0] = *(const f32x4*)sp; I.s[1] = *(const f32x4*)(sp + 4); I.s[2] = *(const f32x4*)(sp + DFF); I.s[3] = *(const f32x4*)(sp + DFF + 4); }
    else if (I.r0 >= 2) { I.a[0] = *(const v4u*)(AV + (size_t)(I.r0 - 2) * 2 * DFF + I.c8); I.a[1] = *(const v4u*)(AV + (size_t)(I.r0 - 1) * 2 * DFF + I.c8); }
}
__device__ __forceinline__ void conv_compute(const ConvItem& I, const float* cw, const float* cb, bf16* ACT, float* out, int l) {
    if (!I.ok) return;
    float x[6][8], w0[8], w1[8], w2[8], bb[8];
    ldf8(cw + I.c8, w0); ldf8(cw + DFF + I.c8, w1); ldf8(cw + 2 * DFF + I.c8, w2); ldf8(cb + I.c8, bb);
#pragma unroll
    for (int i = 0; i < 6; ++i) unpack8(I.a[i], x[i]);
    if (I.smp) {
#pragma unroll
        for (int j = 0; j < 4; ++j) { x[0][j] = I.s[0][j]; x[0][4 + j] = I.s[1][j]; x[1][j] = I.s[2][j]; x[1][4 + j] = I.s[3][j]; } }
#pragma unroll
    for (int i = 0; i < 4; ++i) { float v[8], o[8]; unpack8(I.v[i], v);
#pragma unroll
        for (int j = 0; j < 8; ++j) o[j] = gelu_as(bb[j] + w0[j] * x[i][j] + w1[j] * x[i + 1][j] + w2[j] * x[i + 2][j]) * v[j];
        *(v4u*)(ACT + (size_t)(I.r0 + i) * DFF + I.c8) = pack8(o); }
    float* dst = nullptr;
    if (I.smp) dst = out + O_CVS + ((size_t)l * DECB + (I.r0 - SEQ) / 4) * 2 * DFF + I.c8; else if (I.r0 == SEQ - 4) dst = out + O_CVP + (size_t)l * 2 * DFF + I.c8;
    if (dst) { *(f32x4*)dst = (f32x4){x[4][0], x[4][1], x[4][2], x[4][3]}; *(f32x4*)(dst + 4) = (f32x4){x[4][4], x[4][5], x[4][6], x[4][7]};
        *(f32x4*)(dst + DFF) = (f32x4){x[5][0], x[5][1], x[5][2], x[5][3]}; *(f32x4*)(dst + DFF + 4) = (f32x4){x[5][4], x[5][5], x[5][6], x[5][7]}; }
}
__device__ __forceinline__ void phase_convact(const Ctx& c, int l) {
    PHASE_IDS();
    const bf16* AV = WSP(bf16, WS_P); bf16* ACT = WSP(bf16, WS_ACT);
    const float* cw = c.conv_w + (size_t)l * 3 * DFF; const float* cb = c.conv_b + (size_t)l * DFF;
    const int gt = c.bid * NT + ptid, NGT = c.G * NT; constexpr int NIT = (M / 4) * (DFF / 8);
    for (int it = gt; it < NIT; it += 2 * NGT) {
        ConvItem A, B; conv_load(A, it, NIT, AV, c.state_conv, l); conv_load(B, it + NGT, NIT, AV, c.state_conv, l);
        conv_compute(A, cw, cb, ACT, c.out, l); conv_compute(B, cw, cb, ACT, c.out, l);
    }
}

__device__ __forceinline__ void phase_merge_sample(const Ctx& c) {
    PHASE_IDS();
    const float* PART = WSP(float, WS_PART); bf16* MG = WSP(bf16, WS_MERGED); const int gw = c.bid * NWAVES + pwave, NGW = c.G * NWAVES;
    for (int r = gw; r < NS; r += NGW) { f32x4 v[8];
#pragma unroll
        for (int j = 0; j < 8; ++j) v[j] = (f32x4){0.f, 0.f, 0.f, 0.f};
        for (int ks = 0; ks < 8; ++ks) { const f32x4* pr = (const f32x4*)(PART + ((size_t)ks * NS + r) * DM) + plane;
#pragma unroll
            for (int j = 0; j < 8; ++j) v[j] += pr[64 * j]; }
        v2u* o = (v2u*)(MG + (size_t)(SEQ + r) * DM) + plane;
#pragma unroll
        for (int j = 0; j < 8; ++j) o[64 * j] = (v2u){pk2(v[j].x, v[j].y), pk2(v[j].z, v[j].w)}; }
}

#ifndef NCV0
#define NCV0 24
#endif
#ifndef NCV1
#define NCV1 8
#endif
#ifndef NSW
#define NSW 32
#endif
#ifndef NA_ITEMS
#define NA_ITEMS 16000
#endif
constexpr int NPH = 1 + 12 * DEPTH;
constexpr int RING_BYTES = 131072, MISC_OFF = RING_BYTES, LDS_BYTES = 147456;
#ifdef EMU
void fwd_kernel(void* vp) { const Args& args = *(const Args*)vp; unsigned char* lds = emu_lds;
#else
__global__ void __launch_bounds__(NT, 2) fwd_kernel(Args args) {
    extern __shared__ __attribute__((aligned(16))) unsigned char lds[];
#endif
#ifdef EMU
    const int wave0 = threadIdx.x >> 6;
#define LOADCTX() Ctx c = make_ctx(args, lds, wave0)
#else
    const __attribute__((address_space(4))) char* kp0 = (const __attribute__((address_space(4))) char*)__builtin_amdgcn_kernarg_segment_ptr();
    const int wave0 = __builtin_amdgcn_readfirstlane(threadIdx.x >> 6);
#define LOADCTX() Ctx c = make_ctx(kp0, (LAS unsigned char*)lds, wave0)
#endif
    const int lo = args.ph_lo, hi = args.ph_hi;
#ifndef EMU
    volatile LAS unsigned* misc = (volatile LAS unsigned*)((LAS unsigned char*)lds + MISC_OFF);
    if (threadIdx.x < 16) misc[threadIdx.x] = 0u;
    __syncthreads();
    XcdBarrier bar; bar.bar = (unsigned*)(args.ws + WS_CTL) + 1024; bar.x = 0; bar.st = nullptr; bar.w0 = wave0;
    if (hi - lo > 1) { bar = xcd_barrier_post((unsigned*)(args.ws + WS_CTL) + 1024, misc + 8); bar.w0 = wave0; }
#define SEAM(k) do { if (IN(k) && IN((k) + 1)) xcd_barrier(bar); } while (0)
#else
#define SEAM(k) do { } while (0)
#endif
#define IN(k) in_phase(lo, hi, (k))
#ifndef PH_MASK
#define PH_MASK 0xfff
#endif
#define EN(kind) (((PH_MASK) >> (kind)) & 1)
#ifndef SUB_MASK
#define SUB_MASK 0xffff
#endif
#define SUB(k) (((SUB_MASK) >> (k)) & 1)
    if (EN(0) && IN(0)) { LOADCTX(); phase_prologue(c); }
    SEAM(0);
#pragma unroll 1
    for (int l = 0; l < DEPTH; ++l) {
        const int pb = 12;
        if (l > 0) { if (EN(7) && IN(pb)) { LOADCTX(); phase_rmsnorm(c, c.norm1_g + (size_t)l * DM, c.out + O_Y + (size_t)SEQ * DM, 11, true); } SEAM(pb); }
        const int pA = (l == 0) ? 1 : 13, p0 = pA + 1;
        if (EN(1) && IN(pA)) { LOADCTX();
            const int nu = (NPAN - NPP) * (INC / 256), UW = (nu + 8 <= c.G) ? nu : c.G / 2;
            if (c.bid < UW) {
                pg8::Gemm g{WSP(bf16, WS_XN), l == 0 ? WSP(bf16, WS_WIN) : WSP(bf16, WS_WIN1), DM, DM, DM, c.wave0};
                pg8::EpiIn E{WSP(bf16, WS_P), WSP(float, WS_LOGF), WSP(float, WS_TAB) + T_LB + l * 1024, WSP(float, WS_KVRAW), WSP(v4u, WS_GF)};
                pg8::SchedInS S{NPP, NPAN - NPP, INC / 256, UW, c.bid, 0, DM / 64};
                pg8::gemm_phase<pg8::EpiIn, pg8::SchedInS>(c.lds, g, S, E);
            } else { int tv = c.wave0 * 64 + hw_lane(); OPQ_V(tv); const int wv = __builtin_amdgcn_readfirstlane(tv >> 6);
                tr_stream(c, (LAS float*)(c.lds + wv * 16384), (c.bid - UW) * NWAVES + wv, (c.G - UW) * NWAVES, 1 + l, tv & 63, 0, NA_ITEMS); }
        }
        SEAM(pA);
        if (EN(1) && IN(p0)) { LOADCTX();
            const int NCV = c.G >= 64 ? (l == 0 ? NCV0 : NCV1) : 1;
            if (c.bid < NCV) { int tv = c.wave0 * 64 + hw_lane(); OPQ_V(tv); const int wv = __builtin_amdgcn_readfirstlane(tv >> 6);
                tr_stream(c, (LAS float*)(c.lds + wv * 16384), c.bid * NWAVES + wv, NCV * NWAVES, 1 + l, tv & 63, NA_ITEMS); }
        }
        if (EN(2) && IN(p0)) { LOADCTX();
            const int NCV = c.G >= 64 ? (l == 0 ? NCV0 : NCV1) : 1, SW0 = c.G >= 64 ? NCV : 0, nsw = c.G >= 64 ? NSW : 1;
            if (c.bid >= SW0 && c.bid < SW0 + nsw) { Ctx cs = c; cs.bid = c.bid - SW0; cs.G = nsw;
                mix_mem_sample(cs, l); }
        }
        if (EN(1) && IN(p0)) { LOADCTX();
            pg8::Gemm g{WSP(bf16, WS_XN), l == 0 ? WSP(bf16, WS_WIN) : WSP(bf16, WS_WIN1), DM, DM, DM, c.wave0};
            pg8::EpiIn E{WSP(bf16, WS_P), WSP(float, WS_LOGF), WSP(float, WS_TAB) + T_LB + l * 1024, WSP(float, WS_KVRAW), WSP(v4u, WS_GF)};
            {
                const int NR = c.G >= 64 ? (l == 0 ? NCV0 : NCV1) + NSW : 1, GP = c.G - NR, nextra = l == 0 ? 16 : 0, total = NPP * (INC / 256) + nextra;
                int rs = total / GP; if (rs > 9) rs = 9; const int nstatic = rs * GP;
                unsigned* pool = (unsigned*)(c.ws + WS_CTL) + 8192 + 64 * l; volatile LAS unsigned* slot = (volatile LAS unsigned*)(c.lds + MISC_OFF) + 4;
                pg8::SchedIn S{NPP, INC / 256, GP, c.bid < NR ? 0 : c.bid - NR, nextra, DM / 64, c.bid < NR ? 0 : nstatic};
#pragma unroll 1
                for (;;) {
                    pg8::gemm_phase<pg8::EpiIn, pg8::SchedIn>(c.lds, g, S, E);
                    if (nstatic >= total) break;
                    __syncthreads();
                    if (c.wave0 == 0 && hw_lane() == 0) *slot = atomicAdd(pool, 1u);
                    __syncthreads();
                    const int k = nstatic + (int)*slot; if (k >= total) break;
                    S.G = 1 << 28; S.c = k; S.limit = k + 1;
                }
            }
        }
        SEAM(p0);
        if (EN(2) && IN(p0 + 1)) { LOADCTX();
            const bool alt = ((c.bid >> 3) & 1) != 0;
#pragma unroll 1
            for (int step = 0; step < 2; ++step) {
                if ((step == 0) == alt) { mix_hgrn_local(c, l); }
                else { mix_prep(c, l); if (l == 0) mix_memkv(c); mix_pool(c, l, true, true); mix_hgrn_sample(c, l); }
                __syncthreads();
            }
        }
        SEAM(p0 + 1);
        if (EN(3) && IN(p0 + 2)) { LOADCTX();
            if (SUB(0)) { pg8::Gemm g{WSP(bf16, WS_P) + C_QM, WSP(bf16, WS_KMEM) + (size_t)l * 1024 * 256, INC, 256, 256, c.wave0};
              pg8::SchedGrid S{NPP, 4, c.G, c.bid, 256, 4}; pg8::EpiMemS E{WSP(bf16, WS_E), WSP(float, WS_ROWSUM) + (size_t)l * SEQ * 4};
              pg8::gemm_phase<pg8::EpiMemS, pg8::SchedGrid>(c.lds, g, S, E); }
            __syncthreads();
            if (SUB(6)) { pg8::Gemm g{WSP(bf16, WS_D), WSP(bf16, WS_WPL) + (size_t)l * 1024 * 256, 1024, 256, 256, c.wave0};
              pg8::SchedGrid S{NPAN, 4, c.G, (c.bid + c.G / 2) % c.G, 256, 4}; pg8::EpiBf16S E{WSP(bf16, WS_Y), 4096, 1024, 256, c.pool_scale + (size_t)l * 1024, nullptr, 0};
              pg8::gemm_phase<pg8::EpiBf16S, pg8::SchedGrid>(c.lds, g, S, E); }
            __syncthreads();
            if (SUB(1)) mix_hgrn_scan(c, l); if (SUB(2)) mix_swa_prompt(c, l); mix_swa_sample(c, l);
        }
        SEAM(p0 + 2);
        if (EN(4) && IN(p0 + 3)) { LOADCTX();
            if (SUB(5)) { pg8::Gemm g{WSP(bf16, WS_E), WSP(bf16, WS_VMEMT) + (size_t)l * 1024 * 256, 1024, 256, 256, c.wave0};
              pg8::SchedGrid S{NPP, 4, c.G, c.bid, 256, 4}; pg8::EpiBf16S E{WSP(bf16, WS_Y), 4096, 3072, 256, nullptr, WSP(float, WS_ROWSUM) + (size_t)l * SEQ * 4, 4};
              pg8::gemm_phase<pg8::EpiBf16S, pg8::SchedGrid>(c.lds, g, S, E); }
            __syncthreads();
            if (SUB(6)) { pg8::Gemm g{WSP(bf16, WS_Y), WSP(bf16, WS_WBR) + (size_t)l * 8192 * 1024, 4096, 1024, 1024, c.wave0};
              pg8::SchedBranchS S{NPP, NPAN - NPP, c.G, (c.bid + c.G / 2) % c.G}; pg8::EpiBranch E{WSP(bf16, WS_P), WSP(v4u, WS_GF), WSP(v4u, WS_MACC) + (size_t)c.bid * 8192, WSP(bf16, WS_MERGED), WSP(float, WS_PART)};
              pg8::gemm_phase<pg8::EpiBranch, pg8::SchedBranchS>(c.lds, g, S, E); }
            __syncthreads();
            if (SUB(7)) mix_hgrn_final(c, l);
        }
        SEAM(p0 + 3);
        if (EN(5) && IN(p0 + 4)) { LOADCTX();
            pg8::Gemm g{WSP(bf16, WS_Y), WSP(bf16, WS_WBR) + (size_t)l * 8192 * 1024, 4096, 1024, 1024, c.wave0};
            phase_merge_sample(c);
            pg8::SchedBranch S{NPP, c.G, c.bid}; pg8::EpiBranch E{WSP(bf16, WS_P), WSP(v4u, WS_GF), WSP(v4u, WS_MACC) + (size_t)c.bid * 8192, WSP(bf16, WS_MERGED), WSP(float, WS_PART)};
            pg8::gemm_phase<pg8::EpiBranch, pg8::SchedBranch>(c.lds, g, S, E);
        }
        SEAM(p0 + 4);
        if (EN(6) && IN(p0 + 5)) { LOADCTX();
            pg8::Gemm g{WSP(bf16, WS_MERGED), WSP(bf16, WS_WO) + (size_t)l * DM * DM, DM, DM, DM, c.wave0};
            pg8::SchedSplit S{NPP, NPAN - NPP, c.G, c.bid, 8, DM / 64};
            pg8::EpiRes E{l == 0 ? c.x_prompt : c.out + O_Y, l == 0 ? c.x_sample : c.out + O_Y + (size_t)SEQ * DM, c.out + O_Y, WSP(float, WS_PART)};
            pg8::gemm_phase<pg8::EpiRes, pg8::SchedSplit>(c.lds, g, S, E);
        }
        SEAM(p0 + 5);
        if (EN(7) && IN(p0 + 6)) { LOADCTX(); phase_rmsnorm(c, c.norm2_g + (size_t)l * DM, l == 0 ? c.x_sample : c.out + O_Y + (size_t)SEQ * DM, 8, true); }
        SEAM(p0 + 6);
        if (EN(8) && IN(p0 + 7)) { LOADCTX();
            pg8::Gemm g{WSP(bf16, WS_XN), WSP(bf16, WS_WUP) + (size_t)l * 2 * DFF * DM, DM, DM, DM, c.wave0};
            pg8::SchedGrid S{NPAN, 2 * DFF / 256, c.G, c.bid, 0, DM / 64}; pg8::EpiBf16S E{WSP(bf16, WS_P), 2 * DFF, 0, 256, nullptr, nullptr, 0};
            pg8::gemm_phase<pg8::EpiBf16S, pg8::SchedGrid>(c.lds, g, S, E);
        }
        SEAM(p0 + 7);
        if (EN(9) && IN(p0 + 8)) { LOADCTX(); phase_convact(c, l); }
        SEAM(p0 + 8);
        if (EN(10) && IN(p0 + 9)) { LOADCTX();
            pg8::Gemm g{WSP(bf16, WS_ACT), WSP(bf16, WS_WDN) + (size_t)l * DM * DFF, DFF, DFF, DFF, c.wave0};
            pg8::SchedSplit S{NPP, NPAN - NPP, c.G, c.bid, 11, DFF / 64}; pg8::EpiRes E{c.out + O_Y, c.out + O_Y + (size_t)SEQ * DM, c.out + O_Y, WSP(float, WS_PART)};
            pg8::gemm_phase<pg8::EpiRes, pg8::SchedSplit>(c.lds, g, S, E);
        }
        SEAM(p0 + 9);
    }
    if (EN(7) && IN(NPH - 1)) { LOADCTX(); phase_rmsnorm(c, nullptr, c.out + O_Y + (size_t)SEQ * DM, 11, false); }
#undef IN
#undef SEAM
}

extern "C" void kernel_launch(void* const* d_in, const int* in_sizes, int n_in, void* d_out, int out_size, void* d_ws, size_t ws_size, hipStream_t stream) {
    if (n_in != 30 || (size_t)out_size != O_END || ws_size < WS_END) { fprintf(stderr, "kernel_launch: shape mismatch: n_in %d out %d (want %zu) ws %zu (want %zu)\n", n_in, out_size, (size_t)O_END, ws_size, (size_t)WS_END); return; }
    Args a{};
    for (int i = 0; i < 30; ++i) a.in[i] = (const float*)d_in[i];
    a.out = (float*)d_out; a.ws = (unsigned char*)d_ws;
    (void)hipMemsetAsync((char*)d_ws + WS_CTL, 0, ZERO_BYTES, stream);
#ifdef EMU
    const char* pe = getenv("EMU_PH_LO"); const char* ph = getenv("EMU_PH_HI"); const int plo = pe ? atoi(pe) : 0, phi = ph ? atoi(ph) : NPH;
    for (int p = plo; p < phi; ++p) { a.ph_lo = p; a.ph_hi = p + 1; fprintf(stderr, "[emu] phase %d\n", p); emu_launch(fwd_kernel, &a, getenv("EMU_G") ? atoi(getenv("EMU_G")) : 2, NT, LDS_BYTES); }
#else
    static int grid = 0;
    if (grid == 0) {
        int dev = 0, cus = 0;
        if (hipGetDevice(&dev) != hipSuccess || hipDeviceGetAttribute(&cus, hipDeviceAttributeMultiprocessorCount, dev) != hipSuccess) { grid = -1; return; }
        if (hipFuncSetAttribute((const void*)fwd_kernel, hipFuncAttributeMaxDynamicSharedMemorySize, LDS_BYTES) != hipSuccess) { fprintf(stderr, "kernel_launch: hipFuncSetAttribute failed\n"); grid = -1; return; }
        int per_cu = 0; (void)hipOccupancyMaxActiveBlocksPerMultiprocessor(&per_cu, (const void*)fwd_kernel, NT, LDS_BYTES); (void)hipGetLastError();
        grid = cus;
    }
    if (grid < 0) return;
    if (MK_N_LAUNCHES == 1) { a.ph_lo = 0; a.ph_hi = NPH; hipLaunchKernelGGL(fwd_kernel, dim3(grid), dim3(NT), LDS_BYTES, stream, a); }
    else for (int p = 0; p < NPH; ++p) { a.ph_lo = p; a.ph_hi = p + 1; hipLaunchKernelGGL(fwd_kernel, dim3(grid), dim3(NT), LDS_BYTES, stream, a); }
#endif
}
#ifdef EMU
size_t emu_ws_bytes() { return WS_END; }
size_t emu_out_floats() { return O_END; }
#include "emu_wsmap.h"
#endif
```

```cpp
#ifdef EMU
#include "emu.h"
#else
#include <hip/hip_runtime.h>
#endif
#include <cstdio>
#include <cstdint>

#ifndef CFG_SEQ
#define CFG_SEQ 8192
#endif
#ifndef CFG_DECB
#define CFG_DECB 128
#endif
#ifndef MK_N_LAUNCHES
#define MK_N_LAUNCHES 1
#endif

constexpr int SEQ = CFG_SEQ, DECB = CFG_DECB, NS = DECB * 4, M = SEQ + NS, NPAN = M / 256, NPP = SEQ / 256;
constexpr int DM = 2048, MIXW = 1024, INC = 15872, DFF = 5632, NMEM = 256, DEPTH = 2;
constexpr int C_QA = 0, C_FA = 1024, C_IA = 2048, C_GA = 3072, C_UB = 4096, C_QC = 5120, C_KC = 6144, C_VC = 6400, C_QM = 6656, C_GZ = 7680;
constexpr int SCT = 256, NSC = SEQ / SCT, NCH = SCT / 32;
constexpr int PAST_LEN = 8192;
constexpr float EPS = 1e-6f;
static_assert(SEQ % 256 == 0 && NS % 256 == 0, "row panels");

constexpr size_t O_Y = 0;
constexpr size_t O_HSP = (size_t)M * DM;
constexpr size_t O_HSS = O_HSP + (size_t)DEPTH * 8 * 16384;
constexpr size_t O_PLP = O_HSS + (size_t)DEPTH * DECB * 8 * 16384;
constexpr size_t O_PLS = O_PLP + (size_t)DEPTH * 15 * 1024;
constexpr size_t O_KP = O_PLS + (size_t)DEPTH * DECB * 15 * 1024;
constexpr size_t O_KS = O_KP + (size_t)DEPTH * 128 * 256;
constexpr size_t O_VP = O_KS + (size_t)DEPTH * DECB * 128 * 256;
constexpr size_t O_VS = O_VP + (size_t)DEPTH * 128 * 256;
constexpr size_t O_CVP = O_VS + (size_t)DEPTH * DECB * 128 * 256;
constexpr size_t O_CVS = O_CVP + (size_t)DEPTH * 2 * DFF;
constexpr size_t O_MKP = O_CVS + (size_t)DEPTH * DECB * 2 * DFF;
constexpr size_t O_MVP = O_MKP + (size_t)DEPTH * 256 * 1024;
constexpr size_t O_END = O_MVP + (size_t)DEPTH * 256 * 1024;

constexpr size_t al(size_t x) { return (x + 4095) & ~(size_t)4095; }
constexpr size_t WS_CTL = 0, CTL_BYTES = (size_t)1 << 20;
constexpr size_t WS_ROWSUM = WS_CTL + CTL_BYTES, ROWSUM_BYTES = al((size_t)DEPTH * SEQ * 4 * 4);
constexpr size_t ZERO_BYTES = CTL_BYTES + ROWSUM_BYTES;
constexpr size_t WS_TAB = WS_ROWSUM + ROWSUM_BYTES;
constexpr size_t T_LB = 0, T_COSP = 2048, T_SINP = T_COSP + (size_t)SEQ * 8, T_COSS = T_SINP + (size_t)SEQ * 8, T_SINS = T_COSS + 32, T_END = T_SINS + 32;
constexpr size_t WS_WIN = al(WS_TAB + T_END * 4);
constexpr size_t WIN0_ROWS = INC + 2 * 2048;
constexpr size_t WS_WIN1 = al(WS_WIN + WIN0_ROWS * DM * 2);
constexpr size_t WS_WBR = al(WS_WIN1 + (size_t)INC * DM * 2);
constexpr size_t WS_WO = al(WS_WBR + (size_t)DEPTH * 8192 * 1024 * 2);
constexpr size_t WS_WUP = al(WS_WO + (size_t)DEPTH * DM * DM * 2);
constexpr size_t WS_WDN = al(WS_WUP + (size_t)DEPTH * 2 * DFF * DM * 2);
constexpr size_t WS_WPL = al(WS_WDN + (size_t)DEPTH * DM * DFF * 2);
constexpr size_t WS_XN = al(WS_WPL + (size_t)DEPTH * 1024 * 256 * 2);
constexpr size_t WS_P = al(WS_XN + (size_t)(M + 512) * DM * 2);
constexpr size_t WS_LOGF = al(WS_P + (size_t)M * INC * 2);
constexpr size_t WS_OLOC = al(WS_LOGF + (size_t)M * 1024 * 4);
constexpr size_t WS_U = al(WS_OLOC + (size_t)SEQ * 1024 * 4);
constexpr size_t WS_DTOT = al(WS_U + (size_t)NSC * 8 * 16384 * 4);
constexpr size_t WS_SIN = al(WS_DTOT + (size_t)NSC * 8 * 128 * 4);
constexpr size_t WS_D = al(WS_SIN + (size_t)NSC * 8 * 16384 * 2);
constexpr size_t WS_E = al(WS_D + (size_t)M * 1024 * 2);
constexpr size_t WS_Y = al(WS_E + (size_t)SEQ * 1024 * 2);
constexpr size_t WS_MACC = al(WS_Y + (size_t)M * 4096 * 2);
constexpr size_t WS_MERGED = al(WS_MACC + (size_t)M * DM * 4);
constexpr size_t WS_ACT = al(WS_MERGED + (size_t)M * DM * 2);
constexpr size_t WS_KVRAW = al(WS_ACT + (size_t)M * DFF * 2);
constexpr size_t WS_KMEM = al(WS_KVRAW + (size_t)256 * 4096 * 4);
constexpr size_t WS_VMEMT = al(WS_KMEM + (size_t)DEPTH * 1024 * 256 * 2);
constexpr size_t WS_PART = al(WS_VMEMT + (size_t)DEPTH * 1024 * 256 * 2);
constexpr size_t WS_GF = al(WS_PART + (size_t)11 * NS * DM * 4);
constexpr size_t WS_END = al(WS_GF + (size_t)NPP * 32 * 16 * 512 * 16);

#ifdef EMU
#define LAS
#define ASMV(x)
#define WAVE_LDS_FENCE() emu_wave_sync()
#else
#define LAS __attribute__((address_space(3)))
#define ASMV(x) asm volatile(x ::: "memory")
#define WAVE_LDS_FENCE() asm volatile("s_waitcnt lgkmcnt(0)" ::: "memory")
#endif
#ifdef EMU
#define OPQ_V(x)
#define OPQ_S(x)
#else
#define OPQ_V(x) asm volatile("" : "+v"(x))
#define OPQ_S(x) asm volatile("" : "+s"(x))
#endif
typedef unsigned short bf16;
#ifdef EMU
__device__ __forceinline__ int hw_lane() { return threadIdx.x & 63; }
#else
__device__ __forceinline__ int hw_lane() { return (int)__builtin_amdgcn_mbcnt_hi(~0u, __builtin_amdgcn_mbcnt_lo(~0u, 0u)); }
#endif
template <class T> __device__ __forceinline__ T ldnt(const T* p) { return __builtin_nontemporal_load(p); }
template <class T> __device__ __forceinline__ void stnt(T* p, T v) { __builtin_nontemporal_store(v, p); }
typedef unsigned v4u __attribute__((ext_vector_type(4)));
typedef unsigned v2u __attribute__((ext_vector_type(2)));
typedef float f32x4 __attribute__((ext_vector_type(4)));
typedef float f32x2 __attribute__((ext_vector_type(2)));
typedef short bf16x8 __attribute__((ext_vector_type(8)));
constexpr int NT = 512, NWAVES = 8;
__device__ __forceinline__ unsigned f2bf(float f) { unsigned u = __builtin_bit_cast(unsigned, f); return (u + 0x7fffu + ((u >> 16) & 1u)) >> 16; }
__device__ __forceinline__ float bf2f(unsigned b) { return __builtin_bit_cast(float, b << 16); }
#ifdef EMU
__device__ __forceinline__ unsigned pk2(float lo, float hi) { return f2bf(lo) | (f2bf(hi) << 16); }
__device__ __forceinline__ float frcp(float x) { return 1.0f / x; }
__device__ __forceinline__ float fexp2(float x) { return exp2f(x); }
#else
__device__ __forceinline__ unsigned pk2(float lo, float hi) { unsigned r; asm("v_cvt_pk_bf16_f32 %0, %1, %2" : "=v"(r) : "v"(lo), "v"(hi)); return r; }
__device__ __forceinline__ float frcp(float x) { return __builtin_amdgcn_rcpf(x); }
__device__ __forceinline__ float fexp2(float x) { return __builtin_amdgcn_exp2f(x); }
#endif
__device__ __forceinline__ float bflo(unsigned w) { return __builtin_bit_cast(float, w << 16); }
__device__ __forceinline__ float bfhi(unsigned w) { return __builtin_bit_cast(float, w & 0xffff0000u); }
__device__ __forceinline__ void unpack8(v4u w, float (&f)[8]) { f[0] = bflo(w.x); f[1] = bfhi(w.x); f[2] = bflo(w.y); f[3] = bfhi(w.y); f[4] = bflo(w.z); f[5] = bfhi(w.z); f[6] = bflo(w.w); f[7] = bfhi(w.w); }
__device__ __forceinline__ v4u pack8(const float (&f)[8]) { v4u w; w.x = pk2(f[0], f[1]); w.y = pk2(f[2], f[3]); w.z = pk2(f[4], f[5]); w.w = pk2(f[6], f[7]); return w; }
__device__ __forceinline__ float wave_sum(float v) {
#pragma unroll
    for (int o = 1; o < 64; o <<= 1) v += __shfl_xor(v, o);
    return v;
}
#ifdef EMU
__device__ __forceinline__ float sigmoidf_(float x) { return 1.0f / (1.0f + __expf(-x)); }
#else
__device__ __forceinline__ float sigmoidf_(float x) { return __builtin_amdgcn_rcpf(1.0f + __builtin_amdgcn_exp2f(x * -1.44269504f)); }
#endif
__device__ __forceinline__ float siluf_(float x) { return x * sigmoidf_(x); }
__device__ __forceinline__ float gelu_as(float v) {
    const float av = fabsf(v), t = frcp(av * 0.2316418882f + 1.0f);
    float q = t * 0.5307027145f + (-0.7265760135f); q = q * t + 0.7107068705f; q = q * t + (-0.142248368f); q = q * t + 0.127414796f; q = q * t;
    const float e = fexp2((v * v) * (-0.72134752044f)), m = v * (q * e);
    return v < 0.f ? m : v - m;
}
#ifdef EMU
__device__ __forceinline__ unsigned cvt_pk_bf16(float lo, float hi) { return pk2(lo, hi); }
#else
__device__ __forceinline__ unsigned cvt_pk_bf16(float lo, float hi) { unsigned r; asm volatile("v_cvt_pk_bf16_f32 %0, %1, %2" : "=v"(r) : "v"(lo), "v"(hi)); return r; }
#endif

namespace pg8 {
constexpr int BM = 256, BK = 64, HALF = 128, HTB = HALF * BK * 2, STAGE_BYTES = 8 * HTB, NXCD = 8, WGM = 8;
__host__ __device__ __forceinline__ int lds_byte(int r, int c) { const int st = (r >> 4) * 2 + (c >> 5), rr = r & 15, cc = c & 31, ob = rr * 64 + cc * 2; return st * 1024 + (ob ^ (((ob >> 9) & 1) << 5)); }
__host__ __device__ __forceinline__ void stage_rc(int b, int& R, int& C) { const int st = b / 1024, sb = b % 1024, swz = sb ^ (((sb >> 9) & 1) << 5); R = (st >> 1) * 16 + swz / 64; C = (st & 1) * 32 + (swz % 64) / 2; }
__host__ __device__ __forceinline__ int perm32(int rho) { const int n = rho >> 4, i = rho & 15; return 8 * (i >> 2) + 4 * n + (i & 3); }
struct Unit { int pm, pn, acol, kofs, nt, ks; };
struct Gemm { const bf16* A; const bf16* Bt; int lda, ldb, K, wave0; };
__device__ __forceinline__ bool grid_order(int L, int nM, int nN, int& pm, int& pn) {
    const int nwg = nM * nN; if (L >= nwg) return false;
    int wgid = L; { const int q = nwg / NXCD, r = nwg % NXCD, xcd = wgid % NXCD, off = wgid / NXCD; wgid = (xcd < r ? xcd * (q + 1) : r * (q + 1) + (xcd - r) * q) + off; }
    const int nig = WGM * nN, gid = wgid / nig, fm = gid * WGM, gsz = (nM - fm) < WGM ? (nM - fm) : WGM;
    pm = fm + ((wgid % nig) % gsz); pn = (wgid % nig) / gsz; return true;
}
struct SchedGrid {
    int nM, nN, G, c, acol_step, ntf;
    __device__ __forceinline__ bool next(int i, Unit& u) const { const long L = (long)i * G + c; u.kofs = 0; u.nt = ntf; u.ks = -1; if (L >= (long)nM * nN) return false; if (!grid_order((int)L, nM, nN, u.pm, u.pn)) return false; u.acol = u.pn * acol_step; return true; }
};
struct SchedIn {
    int nM, nN, G, c, nextra, ntf, limit;
    __device__ __forceinline__ bool next(int i, Unit& u) const { const long L = (long)i * G + c; u.acol = 0; u.kofs = 0; u.nt = ntf; u.ks = -1; if (L >= limit) return false;
        if (L < (long)nM * nN) return grid_order((int)L, nM, nN, u.pm, u.pn);
        const int x = (int)(L - (long)nM * nN); if (x >= nextra) return false; u.pm = NPAN + x / 8; u.pn = nN + x; return true; }
};
struct SchedInS {
    int nMp, nMs, nN, G, c, nextra, ntf;
    __device__ __forceinline__ bool next(int i, Unit& u) const { const long L = (long)i * G + c; u.acol = 0; u.kofs = 0; u.nt = ntf; u.ks = -1;
        if (L < (long)nMs * nN) { u.pm = nMp + (int)(L / nN); u.pn = (int)(L % nN); return true; }
        const int x = (int)(L - (long)nMs * nN); if (x >= nextra) return false; u.pm = nMp + nMs + x / 8; u.pn = nN + x; return true; }
};
struct SchedBranch {
    int nM, G, c;
    __device__ __forceinline__ bool next(int i, Unit& u) const { const long su = (long)(i >> 2) * G + c; int pm, pd; u.kofs = 0; u.nt = 16; u.ks = -1; if (su >= (long)nM * 8) return false; if (!grid_order((int)su, nM, 8, pm, pd)) return false;
        const int n = i & 3; u.pm = pm; u.pn = n * 8 + pd; u.acol = n * 1024; return true; }
};

struct SchedBranchS {
    int nMp, nMs, G, c;
    __device__ __forceinline__ bool next(int i, Unit& u) const { const long L = (long)i * G + c; if (L >= (long)nMs * 64) return false;
        const int kh = (int)L & 1, n = ((int)L >> 1) & 3, tile = (int)L >> 3; u.pm = nMp + tile / 8; u.pn = n * 8 + (tile & 7); u.acol = n * 1024; u.kofs = kh * 512; u.nt = 8; u.ks = 2 * n + kh; return true; }
};
struct SchedSplit {
    int nMp, nMs, G, c, nsplit, ntf;
    __device__ __forceinline__ bool next(int i, Unit& u) const { const long L = (long)i * G + c; u.acol = 0;
        if (L < (long)nMp * 8) { u.kofs = 0; u.nt = ntf; u.ks = -1; return grid_order((int)L, nMp, 8, u.pm, u.pn); }
        const int x = (int)(L - (long)nMp * 8); if (x >= nMs * 8 * nsplit) return false;
        const int ks = x % nsplit, tile = x / nsplit; u.pm = nMp + tile / 8; u.pn = tile % 8; u.nt = ntf / nsplit; u.kofs = ks * u.nt * 64; u.ks = ks; return true; }
};

#ifdef EMU
static float emu_C[256 * 256];
static void emu_tile(const Gemm& g, const Unit& u) {
    const int KK = u.nt * 64; static std::vector<float> Af, Bf; Af.resize((size_t)256 * KK); Bf.resize((size_t)256 * KK);
    for (int r = 0; r < 256; ++r) for (int k = 0; k < KK; ++k) { Af[(size_t)r * KK + k] = bf2f(g.A[(size_t)(256 * u.pm + r) * g.lda + u.acol + u.kofs + k]); Bf[(size_t)r * KK + k] = bf2f(g.Bt[(size_t)(256 * u.pn + r) * g.ldb + u.kofs + k]); }
#pragma omp parallel for
    for (int r = 0; r < 256; ++r) for (int c = 0; c < 256; ++c) { const float* a = &Af[(size_t)r * KK]; const float* b = &Bf[(size_t)c * KK]; float s = 0.f; for (int k = 0; k < KK; ++k) s += a[k] * b[k]; emu_C[r * 256 + c] = s; }
}
template <class Epi, class Sched>
void gemm_phase(unsigned char* lds, const Gemm g, const Sched& S, const Epi& E) {
    const int tid = threadIdx.x, wid = tid >> 6, lane = tid & 63, wr = wid >> 2, wc = wid & 3, fr = lane & 15, fq = lane >> 4;
    for (int i = 0;; ++i) { Unit u; if (!S.next(i, u)) break;
        __syncthreads(); if (tid == 0) emu_tile(g, u); __syncthreads();
        f32x4 acc[2][2][4][2];
        for (int ai = 0; ai < 2; ++ai) for (int bj = 0; bj < 2; ++bj) for (int m = 0; m < 4; ++m) for (int n = 0; n < 2; ++n) for (int x = 0; x < 4; ++x) {
            const int row = 128 * ai + 64 * wr + 16 * m + fr, col = Epi::PERM ? 128 * bj + 32 * wc + 8 * fq + 4 * n + x : 128 * bj + 32 * wc + 16 * n + 4 * fq + x; acc[ai][bj][m][n][x] = emu_C[row * 256 + col]; }
        E(acc, u, wr, wc, fr, fq); }
    __syncthreads();
}
#else
template <class Epi, class Sched, bool ALIGN_EPI = true, bool SP2 = true>
__device__ __forceinline__ void gemm_phase(LAS unsigned char* lds, const Gemm g, const Sched& S, const Epi& E) {
    int tid = g.wave0 * 64 + hw_lane(); OPQ_V(tid); const int wid = __builtin_amdgcn_readfirstlane(tid >> 6), lane = tid & 63, wr = wid >> 2, wc = wid & 3, fr = lane & 15, fq = lane >> 4;
    unsigned voffA[2], voffB[2];
#pragma unroll
    for (int i = 0; i < 2; ++i) { int R, C; stage_rc(tid * 16 + i * 8192, R, C); const int Rb = Epi::PERM ? ((R & ~31) + perm32(R & 31)) : R;
        voffA[i] = (unsigned)(R * g.lda + C) * 2u; voffB[i] = (unsigned)(Rb * g.ldb + C) * 2u; }
    const size_t kstep = (size_t)(BK * 2);
    const size_t hstepA = (size_t)HALF * g.lda * 2, hstepB = (size_t)HALF * g.ldb * 2;
    const unsigned ldsw = (unsigned)wid * 1024u;
    const int aoff = lds_byte(wr * 64 + fr, fq * 8), boff = lds_byte(wc * 32 + fr, fq * 8);
#define PG8_SA(b, h) (((b) * 2 + (h)) * HTB)
#define PG8_SB(b, h) ((4 + (b) * 2 + (h)) * HTB)
#define PG8_STAGE(bufoff, gbase, voff) do { _Pragma("unroll") for (int _i = 0; _i < 2; ++_i) \
        __builtin_amdgcn_global_load_lds((const unsigned*)((const char*)(gbase) + (voff)[_i]), (LAS unsigned*)(lds + (bufoff) + ldsw + _i * 8192), 16, 0, 0); } while (0)
#define PG8_LDA(dst, b, h) do { _Pragma("unroll") for (int m = 0; m < 4; ++m) _Pragma("unroll") for (int k = 0; k < 2; ++k) dst[m][k] = *(const LAS bf16x8*)(lds + PG8_SA(b, h) + aoff + m * 2048 + k * 1024); } while (0)
#define PG8_LDB(dst, b, h) do { _Pragma("unroll") for (int n = 0; n < 2; ++n) _Pragma("unroll") for (int k = 0; k < 2; ++k) dst[n][k] = *(const LAS bf16x8*)(lds + PG8_SB(b, h) + boff + n * 2048 + k * 1024); } while (0)
#define PG8_MMA(ai, bj, At, Bt) do { __builtin_amdgcn_s_setprio(1); _Pragma("unroll") for (int m = 0; m < 4; ++m) _Pragma("unroll") for (int n = 0; n < 2; ++n) _Pragma("unroll") for (int k = 0; k < 2; ++k) \
        acc[ai][bj][m][n] = __builtin_amdgcn_mfma_f32_16x16x32_bf16(Bt[n][k], At[m][k], acc[ai][bj][m][n], 0, 0, 0); __builtin_amdgcn_s_setprio(0); } while (0)
#define PG8_WAIT_V(n) asm volatile("s_waitcnt vmcnt(" #n ")" ::: "memory")
#define PG8_WAIT_L(n) asm volatile("s_waitcnt lgkmcnt(" #n ")" ::: "memory")
#define PG8_BAR __builtin_amdgcn_s_barrier()
#define PG8_SCHED __builtin_amdgcn_sched_barrier(0)
    Unit cur, nxt; int ui = 0;
    if (!S.next(0, cur)) return;
    f32x4 acc[2][2][4][2];
#pragma unroll
    for (int a = 0; a < 2; ++a)
#pragma unroll
        for (int b = 0; b < 2; ++b)
#pragma unroll
            for (int m = 0; m < 4; ++m)
#pragma unroll
                for (int n = 0; n < 2; ++n) acc[a][b][m][n] = (f32x4){0.f, 0.f, 0.f, 0.f};
    bf16x8 At[4][2], B0[2][2], B1[2][2];
    const char* cA = (const char*)g.A + ((size_t)cur.pm * 256 * g.lda + cur.acol + cur.kofs) * 2; const char* cB = (const char*)g.Bt + ((size_t)cur.pn * 256 * g.ldb + cur.kofs) * 2;
    if constexpr (SP2) {
        PG8_STAGE(PG8_SB(0, 0), cB, voffB); PG8_STAGE(PG8_SB(0, 1), cB + hstepB, voffB); PG8_STAGE(PG8_SA(0, 0), cA, voffA); PG8_STAGE(PG8_SA(0, 1), cA + hstepA, voffA);
        if (wr == 1) PG8_BAR;
        PG8_WAIT_V(2); PG8_BAR;
        PG8_STAGE(PG8_SB(1, 0), cB + kstep, voffB); PG8_STAGE(PG8_SA(1, 0), cA + kstep, voffA); PG8_STAGE(PG8_SB(1, 1), cB + hstepB + kstep, voffB);
        PG8_WAIT_V(6); PG8_BAR;
    } else {
        PG8_STAGE(PG8_SB(0, 0), cB, voffB); PG8_STAGE(PG8_SA(0, 0), cA, voffA); PG8_STAGE(PG8_SB(0, 1), cB + hstepB, voffB); PG8_STAGE(PG8_SA(0, 1), cA + hstepA, voffA);
        if (wr == 1) PG8_BAR;
        PG8_WAIT_V(4); PG8_BAR;
        PG8_STAGE(PG8_SB(1, 0), cB + kstep, voffB); PG8_STAGE(PG8_SA(1, 0), cA + kstep, voffA); PG8_STAGE(PG8_SB(1, 1), cB + hstepB + kstep, voffB);
        PG8_WAIT_V(6); PG8_BAR;
    }
    for (;;) {
        const bool has_next = S.next(ui + 1, nxt);
        const char* nA = has_next ? (const char*)g.A + ((size_t)nxt.pm * 256 * g.lda + nxt.acol + nxt.kofs) * 2 : cA; const char* nB = has_next ? (const char*)g.Bt + ((size_t)nxt.pn * 256 * g.ldb + nxt.kofs) * 2 : cB;
        int nt = cur.nt; OPQ_S(nt);
        for (int t = 0; t < nt; t += 2) {
            const bool last = (t == nt - 2);
            const char* a1 = cA + (size_t)(t + 1) * kstep;
            const char* a2 = last ? nA : cA + (size_t)(t + 2) * kstep; const char* b2 = last ? nB : cB + (size_t)(t + 2) * kstep;
            const char* a3 = a2 + kstep; const char* b3 = b2 + kstep;
            if constexpr (SP2) {
            PG8_LDB(B0, 0, 0); PG8_LDB(B1, 0, 1); PG8_SCHED; PG8_LDA(At, 0, 0); PG8_STAGE(PG8_SA(1, 1), a1 + hstepA, voffA);
            PG8_WAIT_V(8); PG8_WAIT_L(0); PG8_BAR; PG8_MMA(0, 0, At, B0); PG8_MMA(0, 1, At, B1); PG8_BAR; PG8_SCHED;
            PG8_LDA(At, 0, 1); PG8_STAGE(PG8_SB(0, 0), b2, voffB); PG8_STAGE(PG8_SB(0, 1), b2 + hstepB, voffB); PG8_STAGE(PG8_SA(0, 0), a2, voffA);
            PG8_WAIT_V(8); PG8_WAIT_L(0); PG8_BAR; PG8_MMA(1, 0, At, B0); PG8_MMA(1, 1, At, B1); PG8_BAR; PG8_SCHED;
            PG8_LDB(B0, 1, 0); PG8_LDB(B1, 1, 1); PG8_SCHED; PG8_LDA(At, 1, 0); PG8_STAGE(PG8_SA(0, 1), a2 + hstepA, voffA);
            PG8_WAIT_V(8); PG8_WAIT_L(0); PG8_BAR; PG8_MMA(0, 0, At, B0); PG8_MMA(0, 1, At, B1); PG8_BAR; PG8_SCHED;
            PG8_LDA(At, 1, 1); PG8_STAGE(PG8_SB(1, 0), b3, voffB); PG8_STAGE(PG8_SB(1, 1), b3 + hstepB, voffB); PG8_STAGE(PG8_SA(1, 0), a3, voffA);
            PG8_WAIT_V(8); PG8_WAIT_L(0); PG8_BAR; PG8_MMA(1, 0, At, B0); PG8_MMA(1, 1, At, B1); PG8_BAR; PG8_SCHED;
            } else {
            PG8_LDB(B0, 0, 0); PG8_SCHED; PG8_LDA(At, 0, 0); PG8_STAGE(PG8_SA(1, 1), a1 + hstepA, voffA);
            PG8_WAIT_L(8); PG8_BAR; PG8_WAIT_L(0); PG8_MMA(0, 0, At, B0); PG8_BAR; PG8_SCHED;
            PG8_LDB(B1, 0, 1); PG8_STAGE(PG8_SB(0, 0), b2, voffB);
            PG8_BAR; PG8_WAIT_L(0); PG8_MMA(0, 1, At, B1); PG8_BAR;
            PG8_LDA(At, 0, 1); PG8_STAGE(PG8_SA(0, 0), a2, voffA);
            PG8_BAR; PG8_WAIT_L(0); PG8_MMA(1, 0, At, B0); PG8_BAR; PG8_SCHED;
            PG8_STAGE(PG8_SB(0, 1), b2 + hstepB, voffB);
            PG8_WAIT_V(6); PG8_BAR; PG8_MMA(1, 1, At, B1); PG8_BAR;
            PG8_LDB(B0, 1, 0); PG8_SCHED; PG8_LDA(At, 1, 0); PG8_STAGE(PG8_SA(0, 1), a2 + hstepA, voffA);
            PG8_WAIT_L(8); PG8_BAR; PG8_WAIT_L(0); PG8_MMA(0, 0, At, B0); PG8_BAR; PG8_SCHED;
            PG8_LDB(B1, 1, 1); PG8_STAGE(PG8_SB(1, 0), b3, voffB);
            PG8_BAR; PG8_WAIT_L(0); PG8_MMA(0, 1, At, B1); PG8_BAR;
            PG8_LDA(At, 1, 1); PG8_STAGE(PG8_SA(1, 0), a3, voffA);
            PG8_BAR; PG8_WAIT_L(0); PG8_MMA(1, 0, At, B0); PG8_BAR; PG8_SCHED;
            PG8_STAGE(PG8_SB(1, 1), b3 + hstepB, voffB);
            PG8_WAIT_V(6); PG8_BAR; PG8_MMA(1, 1, At, B1); PG8_BAR;
                    }
        }
        if constexpr (ALIGN_EPI) { if (wr == 0) PG8_BAR; }
        E(acc, cur, wr, wc, fr, fq);
        if (!has_next) break;
#pragma unroll
        for (int a = 0; a < 2; ++a)
#pragma unroll
            for (int b = 0; b < 2; ++b)
#pragma unroll
                for (int m = 0; m < 4; ++m)
#pragma unroll
                    for (int n = 0; n < 2; ++n) acc[a][b][m][n] = (f32x4){0.f, 0.f, 0.f, 0.f};
        cur = nxt; cA = nA; cB = nB; ++ui;
        if constexpr (ALIGN_EPI) { if (wr == 1) PG8_BAR; }
    }
    PG8_WAIT_V(0);
    if constexpr (!ALIGN_EPI) { if (wr == 0) PG8_BAR; }
    PG8_BAR;
#undef PG8_SA
#undef PG8_SB
#undef PG8_STAGE
#undef PG8_LDA
#undef PG8_LDB
#undef PG8_MMA
#undef PG8_WAIT_V
#undef PG8_WAIT_L
#undef PG8_BAR
#undef PG8_SCHED
}
#endif
typedef f32x4 Acc[2][2][4][2];
struct EpiIn {
    static constexpr bool PERM = true;
    bf16* P; float* LOGF; const float* lb; float* KVRAW; v4u* GF;
    __device__ __forceinline__ void operator()(const Acc& acc, const Unit& u, int wr, int wc, int fr, int fq) const {
        int frv = fr; OPQ_V(frv);
        const int rl = wr * 64 + frv, cl = wc * 32 + 8 * fq;
        if (u.pn >= INC / 256) {
            const int cb = (u.pn - INC / 256) * 256 + cl;
#pragma unroll
            for (int ai = 0; ai < 2; ++ai)
#pragma unroll
                for (int m = 0; m < 4; ++m) { float* rp = KVRAW + (size_t)(rl + ai * 128 + m * 16) * 4096 + cb;
#pragma unroll
                    for (int bj = 0; bj < 2; ++bj) { *(f32x4*)(rp + bj * 128) = acc[ai][bj][m][0]; *(f32x4*)(rp + bj * 128 + 4) = acc[ai][bj][m][1]; } }
            return;
        }
        const int pn = u.pn; const int kind = (pn < 4) ? 1 : (pn < 8) ? 3 : (pn < 12) ? 0 : (pn < 16) ? 1 : (pn < 30) ? 0 : 2;
        if (pn >= 30 && u.pm < NPP) {
            v4u* gf = GF + ((size_t)(u.pm * 32 + (pn - 30)) * 16) * 512 + (wr * 4 + wc) * 64 + fq * 16 + frv;
#pragma unroll
            for (int ai = 0; ai < 2; ++ai)
#pragma unroll
                for (int m = 0; m < 4; ++m)
#pragma unroll
                    for (int bj = 0; bj < 2; ++bj) { f32x4 v0 = acc[ai][bj][m][0], v1 = acc[ai][bj][m][1];
#pragma unroll
                        for (int x = 0; x < 4; ++x) { v0[x] = sigmoidf_(v0[x]); v1[x] = sigmoidf_(v1[x]); }
                        v4u w; w.x = cvt_pk_bf16(v0[0], v0[1]); w.y = cvt_pk_bf16(v0[2], v0[3]); w.z = cvt_pk_bf16(v1[0], v1[1]); w.w = cvt_pk_bf16(v1[2], v1[3]);
                        int k = ai * 8 + m * 2 + bj; OPQ_S(k); stnt(gf + (size_t)k * 512, w); }
            return;
        }
        const int row0 = u.pm * 256 + rl, col0 = pn * 256 + cl;
        if (kind == 3) {
#pragma unroll
            for (int bj = 0; bj < 2; ++bj) { const f32x4 l0 = *(const f32x4*)(lb + col0 - C_FA + bj * 128), l1 = *(const f32x4*)(lb + col0 - C_FA + bj * 128 + 4);
#pragma unroll
                for (int ai = 0; ai < 2; ++ai)
#pragma unroll
                    for (int m = 0; m < 4; ++m) { float* rp = LOGF + (size_t)(row0 + ai * 128 + m * 16) * 1024 + (col0 - C_FA) + bj * 128; f32x4 o0, o1;
#pragma unroll
                        for (int x = 0; x < 4; ++x) { o0[x] = logf(l0[x] + (1.f - l0[x]) * sigmoidf_(acc[ai][bj][m][0][x])); o1[x] = logf(l1[x] + (1.f - l1[x]) * sigmoidf_(acc[ai][bj][m][1][x])); }
                        *(f32x4*)rp = o0; *(f32x4*)(rp + 4) = o1; } }
            return;
        }
#pragma unroll
        for (int ai = 0; ai < 2; ++ai)
#pragma unroll
            for (int m = 0; m < 4; ++m) { bf16* rp = P + (size_t)(row0 + ai * 128 + m * 16) * INC + col0;
#pragma unroll
                for (int bj = 0; bj < 2; ++bj) { f32x4 v0 = acc[ai][bj][m][0], v1 = acc[ai][bj][m][1];
                    if (kind == 1) {
#pragma unroll
                        for (int x = 0; x < 4; ++x) { v0[x] = siluf_(v0[x]); v1[x] = siluf_(v1[x]); } }
                    if (kind == 2) {
#pragma unroll
                        for (int x = 0; x < 4; ++x) { v0[x] = sigmoidf_(v0[x]); v1[x] = sigmoidf_(v1[x]); } }
                    v4u w; w.x = cvt_pk_bf16(v0[0], v0[1]); w.y = cvt_pk_bf16(v0[2], v0[3]); w.z = cvt_pk_bf16(v1[0], v1[1]); w.w = cvt_pk_bf16(v1[2], v1[3]);
                    *(v4u*)(rp + bj * 128) = w; } }
    }
};
struct EpiBf16S {
    static constexpr bool PERM = true;
    bf16* O; int ldc, cbase, cstep; const float* colscale; const float* rowsum; int rs_stride;
    __device__ __forceinline__ void operator()(const Acc& acc, const Unit& u, int wr, int wc, int fr, int fq) const {
        const int row0 = u.pm * 256 + wr * 64 + fr, cl = wc * 32 + 8 * fq, col0 = cbase + u.pn * cstep + cl;
        f32x4 s0[2], s1[2];
#pragma unroll
        for (int bj = 0; bj < 2; ++bj) { if (colscale) { s0[bj] = *(const f32x4*)(colscale + u.pn * 256 + cl + bj * 128); s1[bj] = *(const f32x4*)(colscale + u.pn * 256 + cl + bj * 128 + 4); } else { s0[bj] = (f32x4){1.f, 1.f, 1.f, 1.f}; s1[bj] = s0[bj]; } }
#pragma unroll
        for (int ai = 0; ai < 2; ++ai)
#pragma unroll
            for (int m = 0; m < 4; ++m) { const int row = row0 + ai * 128 + m * 16; bf16* rp = O + (size_t)row * ldc + col0;
                const float rs = rowsum ? 1.0f / rowsum[(size_t)row * rs_stride + u.pn] : 1.0f;
#pragma unroll
                for (int bj = 0; bj < 2; ++bj) { const f32x4 v0 = acc[ai][bj][m][0] * s0[bj] * rs, v1 = acc[ai][bj][m][1] * s1[bj] * rs;
                    v4u w; w.x = cvt_pk_bf16(v0[0], v0[1]); w.y = cvt_pk_bf16(v0[2], v0[3]); w.z = cvt_pk_bf16(v1[0], v1[1]); w.w = cvt_pk_bf16(v1[2], v1[3]);
                    *(v4u*)(rp + bj * 128) = w; } }
    }
};
struct EpiMemS {
    static constexpr bool PERM = true;
    bf16* E; float* rowsum;
    __device__ __forceinline__ void operator()(const Acc& acc, const Unit& u, int wr, int wc, int fr, int fq) const {
        const int row0 = u.pm * 256 + wr * 64 + fr, col0 = u.pn * 256 + wc * 32 + 8 * fq;
#pragma unroll
        for (int ai = 0; ai < 2; ++ai)
#pragma unroll
            for (int m = 0; m < 4; ++m) { const int row = row0 + ai * 128 + m * 16; bf16* rp = E + (size_t)row * 1024 + col0; float s = 0.f;
#pragma unroll
                for (int bj = 0; bj < 2; ++bj) { f32x4 v0, v1;
#pragma unroll
                    for (int x = 0; x < 4; ++x) { v0[x] = __expf(acc[ai][bj][m][0][x]); v1[x] = __expf(acc[ai][bj][m][1][x]); }
                    s += (v0[0] + v0[1]) + (v0[2] + v0[3]) + (v1[0] + v1[1]) + (v1[2] + v1[3]);
                    v4u w; w.x = cvt_pk_bf16(v0[0], v0[1]); w.y = cvt_pk_bf16(v0[2], v0[3]); w.z = cvt_pk_bf16(v1[0], v1[1]); w.w = cvt_pk_bf16(v1[2], v1[3]);
                    *(v4u*)(rp + bj * 128) = w; }
                s += __shfl_xor(s, 16); s += __shfl_xor(s, 32);
                if (fq == 0) atomicAdd(rowsum + (size_t)row * 4 + u.pn, s); }
    }
};
struct EpiBranch {
    static constexpr bool PERM = true;
    const bf16* P; const v4u* GF; v4u* MS; bf16* MERGED; float* part;
    __device__ __forceinline__ void operator()(const Acc& acc, const Unit& u, int wr, int wc, int fr, int fq) const {
        const int n = u.pn >> 3, pd = u.pn & 7; const int row0 = u.pm * 256 + wr * 64 + fr, col0 = pd * 256 + wc * 32 + 8 * fq;
        if (u.ks >= 0) {
            float* pb = part + ((size_t)u.ks * NS - SEQ) * DM;
#pragma unroll
            for (int ai = 0; ai < 2; ++ai) { v4u gq[4][2];
#pragma unroll
                for (int m = 0; m < 4; ++m)
#pragma unroll
                    for (int bj = 0; bj < 2; ++bj) gq[m][bj] = *(const v4u*)(P + (size_t)(row0 + ai * 128 + m * 16) * INC + C_GZ + n * 2048 + col0 + bj * 128);
#pragma unroll
                for (int m = 0; m < 4; ++m) { const int row = row0 + ai * 128 + m * 16;
#pragma unroll
                    for (int bj = 0; bj < 2; ++bj) { float g[8]; unpack8(gq[m][bj], g);
                        f32x4 v0 = acc[ai][bj][m][0], v1 = acc[ai][bj][m][1];
#pragma unroll
                        for (int x = 0; x < 4; ++x) { v0[x] *= g[x]; v1[x] *= g[4 + x]; }
                        float* mp = pb + (size_t)row * DM + col0 + bj * 128; *(f32x4*)mp = v0; *(f32x4*)(mp + 4) = v1; } } }
            return; }
        const int ln = (wr * 4 + wc) * 64 + fq * 16 + fr;
        const v4u* gf = GF + ((size_t)(u.pm * 32 + u.pn) * 16) * 512 + ln; v4u* ms = MS + ln;
#pragma unroll
        for (int ai = 0; ai < 2; ++ai)
#pragma unroll
            for (int mh = 0; mh < 2; ++mh) {
                int kb = ai * 8 + mh * 4; OPQ_S(kb);
                v4u gq[4], sq[4];
#pragma unroll
                for (int j = 0; j < 4; ++j) { gq[j] = ldnt(gf + (size_t)(kb + j) * 512); if (n > 0) sq[j] = ms[(size_t)(kb + j) * 512]; }
#pragma unroll
                for (int j = 0; j < 4; ++j) { const int m = mh * 2 + (j >> 1), bj = j & 1; float g[8]; unpack8(gq[j], g);
                    f32x4 v0 = acc[ai][bj][m][0], v1 = acc[ai][bj][m][1];
#pragma unroll
                    for (int x = 0; x < 4; ++x) { v0[x] *= g[x]; v1[x] *= g[4 + x]; }
                    if (n > 0) { float r[8]; unpack8(sq[j], r);
#pragma unroll
                        for (int x = 0; x < 4; ++x) { v0[x] += r[x]; v1[x] += r[4 + x]; } }
                    if (n < 3) { v4u w; w.x = cvt_pk_bf16(v0[0], v0[1]); w.y = cvt_pk_bf16(v0[2], v0[3]); w.z = cvt_pk_bf16(v1[0], v1[1]); w.w = cvt_pk_bf16(v1[2], v1[3]); ms[(size_t)(kb + j) * 512] = w; }
                    else { const int row = row0 + ai * 128 + m * 16; v4u w; w.x = cvt_pk_bf16(v0[0], v0[1]); w.y = cvt_pk_bf16(v0[2], v0[3]); w.z = cvt_pk_bf16(v1[0], v1[1]); w.w = cvt_pk_bf16(v1[2], v1[3]);
                        *(v4u*)(MERGED + (size_t)row * DM + col0 + bj * 128) = w; } }
            }
    }
};
struct EpiRes {
    static constexpr bool PERM = false;
    const float* res_p; const float* res_s; float* out; float* part;
    __device__ __forceinline__ void operator()(const Acc& acc, const Unit& u, int wr, int wc, int fr, int fq) const {
        const int row0 = u.pm * 256 + wr * 64 + fr, col0 = u.pn * 256 + wc * 32 + 4 * fq;
        if (u.ks >= 0) { float* pb = part + ((size_t)u.ks * NS - SEQ) * DM;
#pragma unroll
            for (int ai = 0; ai < 2; ++ai)
#pragma unroll
                for (int m = 0; m < 4; ++m) { const size_t off = (size_t)(row0 + ai * 128 + m * 16) * DM + col0;
#pragma unroll
                    for (int bj = 0; bj < 2; ++bj)
#pragma unroll
                        for (int n = 0; n < 2; ++n) *(f32x4*)(pb + off + bj * 128 + n * 16) = acc[ai][bj][m][n]; }
            return; }
        const float* rbase = (u.pm * 256 < SEQ) ? res_p : res_s - (size_t)SEQ * DM;
#pragma unroll
        for (int ai = 0; ai < 2; ++ai)
#pragma unroll
            for (int mh = 0; mh < 2; ++mh) { f32x4 r[2][2][2];
#pragma unroll
                for (int mm = 0; mm < 2; ++mm) { const size_t off = (size_t)(row0 + ai * 128 + (mh * 2 + mm) * 16) * DM + col0;
#pragma unroll
                    for (int bj = 0; bj < 2; ++bj)
#pragma unroll
                        for (int n = 0; n < 2; ++n) r[mm][bj][n] = ldnt((const f32x4*)(rbase + off + bj * 128 + n * 16)); }
#pragma unroll
                for (int mm = 0; mm < 2; ++mm) { const size_t off = (size_t)(row0 + ai * 128 + (mh * 2 + mm) * 16) * DM + col0;
#pragma unroll
                    for (int bj = 0; bj < 2; ++bj)
#pragma unroll
                        for (int n = 0; n < 2; ++n) *(f32x4*)(out + off + bj * 128 + n * 16) = r[mm][bj][n] + acc[ai][bj][mh * 2 + mm][n]; } }
    }
};
}

#ifndef EMU
#define XB_TMO      128
#define XB_XCNT(j)  (256  + 64 * (j))
#define XB_XSUB(j)  (1280 + 64 * (j))
#define XB_XGEN(j)  (2304 + 64 * (j))
#define XB_TOP      3328
#define XB_TOPGEN   3392
#define XCD_BAR_WORDS 3456
#define XB_SPIN_CAP (1u << 18)
__device__ __forceinline__ unsigned xb_ld(unsigned* p)              { return __hip_atomic_load(p, __ATOMIC_RELAXED, __HIP_MEMORY_SCOPE_AGENT); }
__device__ __forceinline__ unsigned xb_add(unsigned* p, unsigned v) { return __hip_atomic_fetch_add(p, v, __ATOMIC_RELAXED, __HIP_MEMORY_SCOPE_AGENT); }
__device__ __forceinline__ unsigned xb_xcc_id() { return (unsigned)__builtin_amdgcn_s_getreg((3 << 11) | 20) & 0xFu; }
#define XB_SPIN(cond, bar) do { unsigned _sp = 0; while (cond) { __builtin_amdgcn_s_sleep(1); \
    if ((++_sp & 255u) == 0u) { if (xb_ld(&(bar)[XB_TMO])) break; if (_sp > XB_SPIN_CAP) { atomicAdd(&(bar)[XB_TMO], 1u); break; } } } } while (0)
struct XcdBarrier { unsigned* bar; unsigned x; volatile LAS unsigned* st; int w0; };
__device__ __forceinline__ XcdBarrier xcd_barrier_post(unsigned* bar, volatile LAS unsigned* st) {
    XcdBarrier b; b.bar = bar; b.x = xb_xcc_id(); b.st = st;
    if (threadIdx.x == 0) (void)xb_add(&bar[XB_XCNT(b.x)], 1u);
    return b;
}
__device__ __forceinline__ void xcd_barrier_complete(unsigned* bar, unsigned x, unsigned& nloc, unsigned& nx) {
    const unsigned G = gridDim.x * gridDim.y * gridDim.z;
    unsigned sum, cnt, mine, sp = 0u;
    for (;;) {
        sum = 0u; cnt = 0u; mine = 0u;
#pragma unroll
        for (unsigned j = 0; j < 16; ++j) { const unsigned c = xb_ld(&bar[XB_XCNT(j)]); sum += c; cnt += (c > 0u) ? 1u : 0u; mine = (j == x) ? c : mine; }
        if (sum == G) break;
        __builtin_amdgcn_s_sleep(1);
        if ((++sp & 255u) == 0u) { if (xb_ld(&bar[XB_TMO])) break; if (sp > XB_SPIN_CAP) { atomicAdd(&bar[XB_TMO], 1u); break; } }
    }
    nloc = mine > 0u ? mine : 1u; nx = cnt > 0u ? cnt : 1u;
}
__device__ __forceinline__ void xcd_barrier(const XcdBarrier& b) {
    asm volatile("s_waitcnt vmcnt(0)" ::: "memory");
    __syncthreads();
    if (b.w0 == 0 && hw_lane() == 0) {
        unsigned* bar = b.bar;
        __builtin_amdgcn_s_waitcnt(0);
        unsigned nloc = b.st[0], nx = b.st[1];
        if (nloc == 0u) { xcd_barrier_complete(bar, b.x, nloc, nx); b.st[0] = nloc; b.st[1] = nx; }
        const unsigned old = xb_add(&bar[XB_XSUB(b.x)], 1u);
        const unsigned gen = old / nloc;
        if (old + 1u == (gen + 1u) * nloc) {
            __builtin_amdgcn_fence(__ATOMIC_RELEASE, "agent");
            asm volatile("s_waitcnt vmcnt(0)" ::: "memory");
            const unsigned og = xb_add(&bar[XB_TOP], 1u);
            const unsigned tg = og / nx;
            __builtin_amdgcn_fence(__ATOMIC_ACQUIRE, "agent");
            if (og + 1u == (tg + 1u) * nx) xb_add(&bar[XB_TOPGEN], 1u);
            else XB_SPIN(xb_ld(&bar[XB_TOPGEN]) == tg, bar);
            xb_add(&bar[XB_XGEN(b.x)], 1u);
            asm volatile("s_waitcnt vmcnt(0)" ::: "memory");
        } else {
            __builtin_amdgcn_fence(__ATOMIC_ACQUIRE, "agent");
            XB_SPIN(xb_ld(&bar[XB_XGEN(b.x)]) == gen, bar);
            asm volatile("s_waitcnt vmcnt(0)" ::: "memory");
        }
    }
    __syncthreads();
}
#endif

struct Ctx {
    LAS unsigned char* lds; int G, bid, wave0;
    const float *x_prompt, *x_sample, *mem_prompt, *state_hgrn, *cache_pool, *cache_swa_k, *cache_swa_v, *state_conv, *cache_mem_k, *cache_mem_v;
    const float *norm1_g, *w_in, *hgrn_lb, *hgrn_norm_g, *pool_w, *pool_scale, *swa_qnorm_g, *swa_knorm_g, *swa_sinks, *mem_norm_g, *w_mem_kv, *mem_qnorm_g, *mem_knorm_g,
        *w_branch, *w_o, *norm2_g, *w_up, *conv_w, *conv_b, *w_down;
    float* out; unsigned char* ws;
};
#define WSP(T, off) ((T*)(c.ws + (off)))
__device__ __forceinline__ bool in_phase(int lo, int hi, int k) { OPQ_S(lo); OPQ_S(hi); return lo <= k && k < hi; }
#define PHASE_IDS() int ptid = c.wave0 * 64 + hw_lane(); OPQ_V(ptid); const int plane = ptid & 63, pwave = __builtin_amdgcn_readfirstlane(ptid >> 6); (void)plane; (void)pwave

struct Args { const float* in[30]; float* out; unsigned char* ws; int ph_lo, ph_hi; };
#ifdef EMU
__device__ __forceinline__ Ctx make_ctx(const Args& A, unsigned char* lds, int wave0) {
#define CTXF(i) A.in[i]
    Ctx c; c.lds = lds; c.out = A.out; c.ws = A.ws;
#else
__device__ __forceinline__ Ctx make_ctx(const __attribute__((address_space(4))) char* kp, LAS unsigned char* lds, int wave0) {
    OPQ_S(kp);
#define CTXF(i) (((const float* const __attribute__((address_space(4)))*)kp)[i])
    Ctx c; c.lds = lds; c.out = ((float* const __attribute__((address_space(4)))*)kp)[30]; c.ws = ((unsigned char* const __attribute__((address_space(4)))*)kp)[31];
#endif
    c.G = gridDim.x; c.bid = blockIdx.x; c.wave0 = wave0;
    c.x_prompt = CTXF(0); c.x_sample = CTXF(1); c.mem_prompt = CTXF(2); c.state_hgrn = CTXF(3); c.cache_pool = CTXF(4); c.cache_swa_k = CTXF(5); c.cache_swa_v = CTXF(6);
    c.state_conv = CTXF(7); c.cache_mem_k = CTXF(8); c.cache_mem_v = CTXF(9); c.norm1_g = CTXF(10); c.w_in = CTXF(11); c.hgrn_lb = CTXF(12); c.hgrn_norm_g = CTXF(13);
    c.pool_w = CTXF(14); c.pool_scale = CTXF(15); c.swa_qnorm_g = CTXF(16); c.swa_knorm_g = CTXF(17); c.swa_sinks = CTXF(18); c.mem_norm_g = CTXF(19); c.w_mem_kv = CTXF(20);
    c.mem_qnorm_g = CTXF(21); c.mem_knorm_g = CTXF(22); c.w_branch = CTXF(23); c.w_o = CTXF(24); c.norm2_g = CTXF(25); c.w_up = CTXF(26); c.conv_w = CTXF(27); c.conv_b = CTXF(28); c.w_down = CTXF(29);
#undef CTXF
    return c;
}

constexpr int TI_WIN = (DM / 64) * (INC / 32), TI_MKV = (DM / 64) * (2048 / 32), TI_BR = (1024 / 64) * (DM / 32), TI_WO = (DM / 64) * (DM / 32), TI_UP = (DM / 64) * (2 * DFF / 32), TI_DN = (DFF / 64) * (DM / 32), TI_PL = (256 / 64) * (256 / 32);
constexpr int TI_LAYER = TI_WIN + TI_MKV + 4 * TI_BR + TI_WO + TI_UP + TI_DN + 4 * TI_PL, TI_TOTAL = DEPTH * TI_LAYER;
struct TrItem { const float* src; bf16* dst; int ldw, K; };
template <class CtxT> __device__ __forceinline__ TrItem tr_decode(const CtxT& c, int item, int lane) {
    const int l = item / TI_LAYER; int r = item % TI_LAYER; const float* W; bf16* WT; int ldw, K, N;
    if (r < TI_WIN) { W = c.w_in + (size_t)l * DM * INC; ldw = INC; K = DM; N = INC; WT = l == 0 ? WSP(bf16, WS_WIN) : WSP(bf16, WS_WIN1); }
    else if ((r -= TI_WIN) < TI_MKV) { W = c.w_mem_kv + (size_t)l * DM * 2048; ldw = 2048; K = DM; N = 2048; WT = WSP(bf16, WS_WIN) + (size_t)(INC + 2048 * l) * DM; }
    else if ((r -= TI_MKV) < 4 * TI_BR) { const int n = r / TI_BR; r -= n * TI_BR; W = c.w_branch + ((size_t)l * 4 + n) * 1024 * DM; ldw = DM; K = 1024; N = DM; WT = WSP(bf16, WS_WBR) + ((size_t)l * 4 + n) * 2048 * 1024; }
    else if ((r -= 4 * TI_BR) < TI_WO) { W = c.w_o + (size_t)l * DM * DM; ldw = DM; K = DM; N = DM; WT = WSP(bf16, WS_WO) + (size_t)l * DM * DM; }
    else if ((r -= TI_WO) < TI_UP) { W = c.w_up + (size_t)l * DM * 2 * DFF; ldw = 2 * DFF; K = DM; N = 2 * DFF; WT = WSP(bf16, WS_WUP) + (size_t)l * 2 * DFF * DM; }
    else if ((r -= TI_UP) < TI_DN) { W = c.w_down + (size_t)l * DFF * DM; ldw = DM; K = DFF; N = DM; WT = WSP(bf16, WS_WDN) + (size_t)l * DM * DFF; }
    else { r -= TI_DN; const int g = r / TI_PL; r -= g * TI_PL; W = c.pool_w + ((size_t)l * 4 + g) * 65536; ldw = 256; K = 256; N = 256; WT = WSP(bf16, WS_WPL) + ((size_t)l * 4 + g) * 65536; }
    const int nblk = N / 32, kb = r / nblk, nb = r % nblk, k0 = 64 * kb, n0 = 32 * nb;
    TrItem t; t.src = W + (size_t)(k0 + (lane >> 3)) * ldw + n0 + (lane & 7) * 4; t.dst = WT + (size_t)(n0 + (lane >> 3)) * K + k0 + 8 * (lane & 7); t.ldw = ldw; t.K = K; return t;
}
__device__ __forceinline__ void tr_load(const TrItem& t, f32x4 (&r)[8]) {
#pragma unroll
    for (int i = 0; i < 8; ++i) r[i] = ldnt((const f32x4*)(t.src + (size_t)(8 * i) * t.ldw));
}
__device__ __forceinline__ void tr_store(const TrItem& t, const f32x4 (&r)[8], LAS float* scr, int lane, bool nts) {
#pragma unroll
    for (int i = 0; i < 8; ++i) { const int kk = 8 * i + (lane >> 3), n4 = (lane & 7) * 4; scr[kk * 33 + n4] = r[i].x; scr[kk * 33 + n4 + 1] = r[i].y; scr[kk * 33 + n4 + 2] = r[i].z; scr[kk * 33 + n4 + 3] = r[i].w; }
    WAVE_LDS_FENCE();
    const int cc = lane & 7;
#pragma unroll
    for (int j = 0; j < 4; ++j) { const int n = (lane >> 3) + 8 * j; const LAS float* s = scr + (8 * cc) * 33 + n;
        v4u o; o.x = pk2(s[0 * 33], s[1 * 33]); o.y = pk2(s[2 * 33], s[3 * 33]); o.z = pk2(s[4 * 33], s[5 * 33]); o.w = pk2(s[6 * 33], s[7 * 33]);
        if (nts) stnt((v4u*)(t.dst + (size_t)(8 * j) * t.K), o); else *(v4u*)(t.dst + (size_t)(8 * j) * t.K) = o; }
    WAVE_LDS_FENCE();
}
constexpr int TI_REST = TI_LAYER - TI_WIN - TI_MKV;
constexpr int TI_PART0 = TI_WIN + 2 * TI_MKV, TI_PART1 = TI_REST + TI_WIN, TI_PART2 = TI_REST;
static_assert(TI_PART0 + TI_PART1 + TI_PART2 == TI_TOTAL, "conversion parts");
__device__ __forceinline__ int tr_map(int j, int part) {
    if (part == 0) return j < TI_WIN + TI_MKV ? j : TI_LAYER + TI_WIN + (j - TI_WIN - TI_MKV);
    if (part == 1) return j < TI_REST ? TI_WIN + TI_MKV + j : TI_LAYER + (j - TI_REST);
    return TI_LAYER + TI_WIN + TI_MKV + j;
}
template <class CtxT> __device__ __forceinline__ void tr_stream(const CtxT& c, LAS float* scr, int wid, int nw, int part, int lane, int j0 = 0, int j1 = 1 << 30) {
    const int ptotal = part == 0 ? TI_PART0 : part == 1 ? TI_PART1 : TI_PART2; const int total = j1 < ptotal ? j1 : ptotal;
    int it = j0 + wid; f32x4 ra[8], rb[8]; TrItem ta, tb; ta = tr_decode(c, tr_map(it < total ? it : 0, part), lane); tb = ta;
    if (it < total) tr_load(ta, ra);
    while (it < total) { const int nit = it + nw;
        if (nit < total) { tb = tr_decode(c, tr_map(nit, part), lane); tr_load(tb, rb); }
        tr_store(ta, ra, scr, lane, part != 0);
#pragma unroll
        for (int i = 0; i < 8; ++i) ra[i] = rb[i];
        ta = tb; it = nit; }
}
__device__ __forceinline__ void rms_row(const float* xrow, const float* g, bf16* orow, int lane) {
    const f32x4* xr = (const f32x4*)xrow + lane; const f32x4* gr = (const f32x4*)g + lane;
    f32x4 v[8]; float s = 0.f;
#pragma unroll
    for (int j = 0; j < 8; ++j) { v[j] = xr[64 * j]; s += (v[j].x * v[j].x + v[j].y * v[j].y) + (v[j].z * v[j].z + v[j].w * v[j].w); }
    const float rstd = 1.0f / sqrtf(wave_sum(s) * (1.f / DM) + EPS);
    v2u* o8 = (v2u*)orow + lane;
#pragma unroll
    for (int j = 0; j < 8; ++j) { const f32x4 gg = gr[64 * j]; v2u w; w.x = pk2(v[j].x * rstd * gg.x, v[j].y * rstd * gg.y); w.y = pk2(v[j].z * rstd * gg.z, v[j].w * rstd * gg.w); o8[64 * j] = w; }
}
__device__ __forceinline__ void rms_row2(const float* x0, bf16* o0, const float* x1, bf16* o1, const float* g, int lane) {
    const f32x4* xa = (const f32x4*)x0 + lane; const f32x4* xb = (const f32x4*)(x1 ? x1 : x0) + lane; const f32x4* gr = (const f32x4*)g + lane;
    f32x4 va[8], vb[8]; float sa = 0.f, sb = 0.f;
#pragma unroll
    for (int j = 0; j < 8; ++j) { va[j] = xa[64 * j]; vb[j] = xb[64 * j]; }
#pragma unroll
    for (int j = 0; j < 8; ++j) { sa += (va[j].x * va[j].x + va[j].y * va[j].y) + (va[j].z * va[j].z + va[j].w * va[j].w); sb += (vb[j].x * vb[j].x + vb[j].y * vb[j].y) + (vb[j].z * vb[j].z + vb[j].w * vb[j].w); }
    const float ra = 1.0f / sqrtf(wave_sum(sa) * (1.f / DM) + EPS), rb = 1.0f / sqrtf(wave_sum(sb) * (1.f / DM) + EPS);
    v2u* pa = (v2u*)o0 + lane; v2u* pb = (v2u*)o1 + lane;
#pragma unroll
    for (int j = 0; j < 8; ++j) { const f32x4 gg = gr[64 * j]; pa[64 * j] = (v2u){pk2(va[j].x * ra * gg.x, va[j].y * ra * gg.y), pk2(va[j].z * ra * gg.z, va[j].w * ra * gg.w)};
        if (x1) pb[64 * j] = (v2u){pk2(vb[j].x * rb * gg.x, vb[j].y * rb * gg.y), pk2(vb[j].z * rb * gg.z, vb[j].w * rb * gg.w)}; }
}
__device__ __forceinline__ const float* xrow_in(const Ctx& c, int r) { return r < SEQ ? c.x_prompt + (size_t)r * DM : c.x_sample + (size_t)(r - SEQ) * DM; }

__device__ __forceinline__ void phase_prologue(const Ctx& c) {
    PHASE_IDS();
    LAS float* scr = (LAS float*)(c.lds + pwave * 16384);
    const int gw = c.bid * NWAVES + pwave, NGW = c.G * NWAVES;
    tr_stream(c, scr, gw, NGW, 0, plane);
    float* tab = WSP(float, WS_TAB);
    const int gt = c.bid * NT + ptid, NGT = c.G * NT;
    for (int i = gt; i < 2048; i += NGT) { const int col = i & 1023; float v = 0.f; if (i >= 1024) { const float a0 = c.hgrn_lb[col], a1 = c.hgrn_lb[1024 + col]; v = 1.0f / (1.0f + expf(a0 - a1)); } tab[T_LB + i] = v; }
    for (int i = gt; i < (SEQ + 4) * 8; i += NGT) { const int p = i >> 3, k = i & 7; const float inv = powf(500000.0f, -(float)(2 * k) / 16.0f); const float pos = (p < SEQ) ? (float)p : (float)(PAST_LEN + (p - SEQ));
        const float ang = pos * inv; const float cs = (float)cos((double)ang), sn = (float)sin((double)ang);
        if (p < SEQ) { tab[T_COSP + i] = cs; tab[T_SINP + i] = sn; } else { tab[T_COSS + (i - SEQ * 8)] = cs; tab[T_SINS + (i - SEQ * 8)] = sn; } }
    bf16* XN = WSP(bf16, WS_XN);
    for (int r = gw; r < M + 512; r += NGW) {
        if (r < M) rms_row(xrow_in(c, r), c.norm1_g, XN + (size_t)r * DM, plane);
        else { const int l = (r - M) >> 8, s = (r - M) & 255; rms_row(c.mem_prompt + (size_t)s * DM, c.mem_norm_g + (size_t)l * DM, XN + (size_t)r * DM, plane); }
    }
}

__device__ __forceinline__ void fix_row(const float* res, const float* part, int nsplit, float* dst, int lane) {
    const f32x4* xr = (const f32x4*)res + lane; f32x4 v[8];
#pragma unroll
    for (int j = 0; j < 8; ++j) v[j] = xr[64 * j];
    for (int ks = 0; ks < nsplit; ++ks) { const f32x4* pr = (const f32x4*)(part + (size_t)ks * NS * DM) + lane;
#pragma unroll
        for (int j = 0; j < 8; ++j) v[j] += ldnt(pr + 64 * j); }
    f32x4* o = (f32x4*)dst + lane;
#pragma unroll
    for (int j = 0; j < 8; ++j) o[64 * j] = v[j];
}
__device__ __forceinline__ void phase_rmsnorm(const Ctx& c, const float* g, const float* res_s, int nsplit, bool norm) {
    PHASE_IDS();
    bf16* XN = WSP(bf16, WS_XN); const float* PART = WSP(float, WS_PART); const int gw = c.bid * NWAVES + pwave, NGW = c.G * NWAVES;
    for (int r = gw; r < NS; r += NGW) { float* row = c.out + O_Y + (size_t)(SEQ + r) * DM; fix_row(res_s + (size_t)r * DM, PART + (size_t)r * DM, nsplit, row, plane);
        if (norm) rms_row(row, g, XN + (size_t)(SEQ + r) * DM, plane); }
    if (!norm) return;
    for (int r = gw; r < SEQ; r += 2 * NGW) { const int r2 = r + NGW; rms_row2(c.out + O_Y + (size_t)r * DM, XN + (size_t)r * DM, r2 < SEQ ? c.out + O_Y + (size_t)r2 * DM : nullptr, XN + (size_t)r2 * DM, g, plane); }
}

__device__ __forceinline__ void mix_prep(const Ctx& c, int l) {
    PHASE_IDS();
    bf16* P = WSP(bf16, WS_P); const float* tab = WSP(float, WS_TAB);
    const int gw = c.bid * NWAVES + pwave, NGW = c.G * NWAVES, lane = plane, sub = lane & 7, grp = lane >> 3;
    const float* qg = c.swa_qnorm_g + l * 64; const float* kg = c.swa_knorm_g + l * 64; const float* mg = c.mem_qnorm_g + l * 256;
    for (int r = gw; r < SEQ; r += NGW) {
        const float* cs = (r < SEQ) ? tab + T_COSP + (size_t)r * 8 : tab + T_COSS + ((r - SEQ) & 3) * 8;
        const float* sn = (r < SEQ) ? tab + T_SINP + (size_t)r * 8 : tab + T_SINS + ((r - SEQ) & 3) * 8;
        v4u raw[3]; const int hm = lane >> 4, s16 = lane & 15; bf16* pmq = P + (size_t)r * INC + C_QM + hm * 256 + s16 * 8;
#pragma unroll
        for (int pass = 0; pass < 3; ++pass) raw[pass] = *(const v4u*)(P + (size_t)r * INC + C_QC + (pass * 8 + grp) * 64 + sub * 8);
        const v4u rawa = *(const v4u*)pmq, rawb = *(const v4u*)(pmq + 128);
#pragma unroll
        for (int pass = 0; pass < 3; ++pass) {
            const int hd = pass * 8 + grp;
            bf16* p = P + (size_t)r * INC + C_QC + hd * 64 + sub * 8;
            float f[8]; unpack8(raw[pass], f);
            {
                const bool nrm = hd < 20;
                float ss = 0.f;
#pragma unroll
                for (int j = 0; j < 8; ++j) ss += f[j] * f[j];
                ss += __shfl_xor(ss, 1); ss += __shfl_xor(ss, 2); ss += __shfl_xor(ss, 4);
                const float rstd = 1.0f / sqrtf(ss * (1.f / 64.f) + EPS); const float* g = (hd < 16) ? qg : kg;
                if (nrm) {
#pragma unroll
                    for (int j = 0; j < 8; ++j) f[j] = f[j] * rstd * g[sub * 8 + j]; }
                float o[8];
#pragma unroll
                for (int j = 0; j < 8; ++j) o[j] = __shfl_xor(f[j], 1);
                if (nrm && sub == 0) {
#pragma unroll
                    for (int j = 0; j < 8; ++j) f[j] = f[j] * cs[j] - o[j] * sn[j]; }
                else if (nrm && sub == 1) {
#pragma unroll
                    for (int j = 0; j < 8; ++j) f[j] = f[j] * cs[j] + o[j] * sn[j]; }
                if (hd < 16) {
#pragma unroll
                    for (int j = 0; j < 8; ++j) f[j] *= 0.125f; }
                if (nrm) *(v4u*)p = pack8(f);
            }
            if (hd >= 16) {
                const int kh = (hd - 16) & 3; const size_t ob = (hd < 20) ? O_KP : O_VP, os = (hd < 20) ? O_KS : O_VS;
                float* dst = nullptr;
                if (r < SEQ) { if (r >= SEQ - 128) dst = c.out + ob + ((size_t)l * 128 + (r - (SEQ - 128))) * 256 + kh * 64 + sub * 8; }
                else { const int b = (r - SEQ) >> 2, i = (r - SEQ) & 3; dst = c.out + os + (((size_t)l * DECB + b) * 128 + 124 + i) * 256 + kh * 64 + sub * 8; }
                if (dst) { *(f32x4*)dst = (f32x4){f[0], f[1], f[2], f[3]}; *(f32x4*)(dst + 4) = (f32x4){f[4], f[5], f[6], f[7]}; }
            }
        }
        { bf16* p = pmq; float a[8], b[8]; unpack8(rawa, a); unpack8(rawb, b);
            float ss = 0.f;
#pragma unroll
            for (int j = 0; j < 8; ++j) ss += a[j] * a[j] + b[j] * b[j];
            ss += __shfl_xor(ss, 1); ss += __shfl_xor(ss, 2); ss += __shfl_xor(ss, 4); ss += __shfl_xor(ss, 8);
            const float rstd = 0.0625f / sqrtf(ss * (1.f / 256.f) + EPS);
#pragma unroll
            for (int j = 0; j < 8; ++j) { a[j] *= rstd * mg[s16 * 8 + j]; b[j] *= rstd * mg[128 + s16 * 8 + j]; }
            *(v4u*)p = pack8(a); *(v4u*)(p + 128) = pack8(b); }
    }
}
__device__ __forceinline__ void mix_memkv(const Ctx& c) {
    PHASE_IDS();
    const float* KV = WSP(float, WS_KVRAW); bf16* KM = WSP(bf16, WS_KMEM); bf16* VT = WSP(bf16, WS_VMEMT);
    const int gw = c.bid * NWAVES + pwave, NGW = c.G * NWAVES, lane = plane;
    for (int it = gw; it < 2 * 256 * 4; it += NGW) {
        const int l = it >> 10, s = (it >> 2) & 255, hm = it & 3;
        const float* kr = KV + (size_t)s * 4096 + l * 2048 + hm * 256; const float* vr = kr + 1024;
        const f32x4 k4 = *(const f32x4*)(kr + lane * 4), v4 = *(const f32x4*)(vr + lane * 4);
        const float ss = wave_sum((k4.x * k4.x + k4.y * k4.y) + (k4.z * k4.z + k4.w * k4.w)); const float rstd = 1.0f / sqrtf(ss * (1.f / 256.f) + EPS);
        const f32x4 g4 = *(const f32x4*)(c.mem_knorm_g + l * 256 + lane * 4); const f32x4 kn = k4 * rstd * g4;
        *(f32x4*)(c.out + O_MKP + ((size_t)l * 256 + s) * 1024 + hm * 256 + lane * 4) = kn;
        *(f32x4*)(c.out + O_MVP + ((size_t)l * 256 + s) * 1024 + hm * 256 + lane * 4) = v4;
        v2u w; w.x = pk2(kn.x, kn.y); w.y = pk2(kn.z, kn.w); *(v2u*)(KM + (((size_t)l * 4 + hm) * 256 + s) * 256 + lane * 4) = w;
        bf16* vt = VT + (((size_t)l * 4 + hm) * 256 + lane * 4) * 256 + s;
        vt[0] = (bf16)f2bf(v4.x); vt[256] = (bf16)f2bf(v4.y); vt[512] = (bf16)f2bf(v4.z); vt[768] = (bf16)f2bf(v4.w);
    }
}
__device__ __forceinline__ void ld8(const bf16* p, float (&f)[8]) { unpack8(*(const v4u*)p, f); }
__device__ __forceinline__ void mix_pool(const Ctx& c, int l, bool prompt_part, bool sample_part) {
    PHASE_IDS();
    const bf16* __restrict__ P = WSP(bf16, WS_P); bf16* __restrict__ D = WSP(bf16, WS_D);
    const int gt = c.bid * NT + ptid, NGT = c.G * NT;
    constexpr int NPI = (SEQ / 32) * 128;
    for (int it = gt + (prompt_part ? 0 : NPI); it < (sample_part ? NPI + NS * 128 : NPI); it += NGT) {
        if (it < NPI) {
            const int R0 = (it >> 7) * 32, c8 = (it & 127) * 8, win = 2 << (c8 >> 8); const bf16* ub = P + C_UB + c8;
            float S[8];
#pragma unroll
            for (int j = 0; j < 8; ++j) S[j] = 0.f;
            for (int k = 1; k <= win; ++k) if (R0 - k >= 0) { float t[8]; ld8(ub + (size_t)(R0 - k) * INC, t);
#pragma unroll
                for (int j = 0; j < 8; ++j) S[j] += t[j]; }
#pragma unroll 8
            for (int i = 0; i < 32; ++i) { const int t = R0 + i; float u[8], o[8]; ld8(ub + (size_t)t * INC, u);
                if (t - win >= 0) ld8(ub + (size_t)(t - win) * INC, o); else {
#pragma unroll
                    for (int j = 0; j < 8; ++j) o[j] = 0.f; }
                const float ic = frcp((float)((t + 1 < win) ? t + 1 : win)); float d[8];
#pragma unroll
                for (int j = 0; j < 8; ++j) { S[j] += u[j] - o[j]; d[j] = S[j] * ic - u[j]; }
                *(v4u*)(D + (size_t)t * 1024 + c8) = pack8(d);
                if (t >= SEQ - 15) { float* __restrict__ op = c.out + O_PLP + ((size_t)l * 15 + (t - (SEQ - 15))) * 1024 + c8; *(f32x4*)op = (f32x4){u[0], u[1], u[2], u[3]}; *(f32x4*)(op + 4) = (f32x4){u[4], u[5], u[6], u[7]}; } }
        } else {
            const int it2 = it - NPI, r = SEQ + (it2 >> 7), c8 = (it2 & 127) * 8, win = 2 << (c8 >> 8);
            float u[8], s[8]; ld8(P + (size_t)r * INC + C_UB + c8, u);
#pragma unroll
            for (int j = 0; j < 8; ++j) s[j] = u[j];
            const int b = (r - SEQ) >> 2, i = (r - SEQ) & 3;
            for (int k = 1; k < win; ++k) { const int e = 15 + i - k; float t[8];
                if (e >= 15) ld8(P + (size_t)(r - k) * INC + C_UB + c8, t);
                else { const float* cp = c.cache_pool + (((size_t)l * DECB + b) * 15 + e) * 1024 + c8; const f32x4 a = *(const f32x4*)cp, bb = *(const f32x4*)(cp + 4); t[0] = a.x; t[1] = a.y; t[2] = a.z; t[3] = a.w; t[4] = bb.x; t[5] = bb.y; t[6] = bb.z; t[7] = bb.w; }
#pragma unroll
                for (int j = 0; j < 8; ++j) s[j] += t[j]; }
            const float ic = 1.0f / (float)win; float d[8];
#pragma unroll
            for (int j = 0; j < 8; ++j) d[j] = s[j] * ic - u[j];
            *(v4u*)(D + (size_t)r * 1024 + c8) = pack8(d);
            float* ob = c.out + O_PLS + ((size_t)l * DECB + b) * 15 * 1024 + c8;
            *(f32x4*)(ob + (size_t)(11 + i) * 1024) = (f32x4){u[0], u[1], u[2], u[3]}; *(f32x4*)(ob + (size_t)(11 + i) * 1024 + 4) = (f32x4){u[4], u[5], u[6], u[7]};
            for (int j = i; j < 11; j += 4) { const float* cp = c.cache_pool + (((size_t)l * DECB + b) * 15 + j + 4) * 1024 + c8; *(f32x4*)(ob + (size_t)j * 1024) = *(const f32x4*)cp; *(f32x4*)(ob + (size_t)j * 1024 + 4) = *(const f32x4*)(cp + 4); }
        }
    }
}
#define MFMA16(a, b, cc) __builtin_amdgcn_mfma_f32_16x16x32_bf16((a), (b), (cc), 0, 0, 0)
__device__ __forceinline__ void mix_hgrn_local(const Ctx& c, int l) {
    PHASE_IDS();
    bf16* P = WSP(bf16, WS_P); const float* LOGF = WSP(float, WS_LOGF); float* OLOC = WSP(float, WS_OLOC); float* U = WSP(float, WS_U); float* DTOT = WSP(float, WS_DTOT);
    LAS bf16* QT = (LAS bf16*)(c.lds); LAS bf16* KT = (LAS bf16*)(c.lds + 8704); LAS bf16* KTT = (LAS bf16*)(c.lds + 17408); LAS bf16* VT = (LAS bf16*)(c.lds + 27648);
    LAS bf16* SLT = (LAS bf16*)(c.lds + 37888); LAS float* EBL = (LAS float*)(c.lds + 72704); LAS float* PART = (LAS float*)(c.lds + 73216);
    const int tid = ptid, lane = plane, w = pwave, d = tid & 127, tq = tid >> 7, lr = lane & 15, g = lane >> 4;
    float lf[8], lfn[8]; unsigned qr[8], qrn[8], vr[8], vrn[8];
#define HL_LOAD(LF, QR, VR, UNIT, CH) do { const int _h = (UNIT) & 7, _t0 = ((UNIT) >> 3) * SCT + 32 * (CH) + 8 * tq; _Pragma("unroll") for (int j = 0; j < 8; ++j) { \
        LF[j] = ldnt(LOGF + (size_t)(_t0 + j) * 1024 + _h * 128 + d); QR[j] = P[(size_t)(_t0 + j) * INC + C_QA + _h * 128 + d]; VR[j] = P[(size_t)(_t0 + j) * INC + C_IA + _h * 128 + d]; } } while (0)
    int unit = c.bid, ch = 0; bool have = unit < 8 * NSC;
    if (have) HL_LOAD(lf, qr, vr, unit, ch);
    f32x4 Sl[8]; float Bprev = 0.f;
#pragma unroll 1
    while (have) {
        const int h = unit & 7, sc = unit >> 3, T0 = sc * SCT;
        if (ch == 0) { Bprev = 0.f;
#pragma unroll
            for (int db = 0; db < 8; ++db) { Sl[db] = (f32x4){0.f, 0.f, 0.f, 0.f}; *(LAS v2u*)(SLT + (16 * w + lr) * 136 + 16 * db + 4 * g) = (v2u){0u, 0u}; } }
        {
            const int t0 = T0 + 32 * ch + 8 * tq;
            float pb[8]; float run = 0.f;
#pragma unroll
            for (int j = 0; j < 8; ++j) { run += lf[j]; pb[j] = run; }
            PART[tq * 128 + d] = run;
            __syncthreads();
            float off = 0.f, bl = 0.f;
#pragma unroll
            for (int q = 0; q < 4; ++q) { const float pq = PART[q * 128 + d]; if (q < tq) off += pq; bl += pq; }
            unsigned ktp[4], vtp[4];
#pragma unroll
            for (int j = 0; j < 8; ++j) {
                const float b = off + pb[j]; bf16* qp = P + (size_t)(t0 + j) * INC + C_QA + h * 128 + d;
                const float q = bf2f(qr[j]); const unsigned vb = vr[j];
                const float eb = __expf(b), einv = __expf(fminf(-b, 80.f)), kk = 1.0f - __expf(lf[j]);
                const float qt = q * eb, kt = kk * einv; const unsigned qtb = f2bf(qt), ktb = f2bf(kt);
                QT[(8 * tq + j) * 136 + d] = (bf16)qtb; KT[(8 * tq + j) * 136 + d] = (bf16)ktb;
                if (j & 1) { ktp[j >> 1] |= ktb << 16; vtp[j >> 1] |= vb << 16; } else { ktp[j >> 1] = ktb; vtp[j >> 1] = vb; }
                *qp = (bf16)f2bf(qt * __expf(Bprev));
            }
            *(LAS v4u*)(KTT + d * 40 + 8 * tq) = (v4u){ktp[0], ktp[1], ktp[2], ktp[3]};
            *(LAS v4u*)(VT + d * 40 + 8 * tq) = (v4u){vtp[0], vtp[1], vtp[2], vtp[3]};
            if (tq == 0) EBL[d] = __expf(bl);
            Bprev += bl;
            __syncthreads();
            int nunit = unit, nch = ch + 1; if (nch == NCH) { nch = 0; nunit += c.G; }
            const bool nhave = nunit < 8 * NSC;
            if (nhave) HL_LOAD(lfn, qrn, vrn, nunit, nch);
            bf16x8 qf[2][4];
#pragma unroll
            for (int tb = 0; tb < 2; ++tb)
#pragma unroll
                for (int ks = 0; ks < 4; ++ks) qf[tb][ks] = *(const LAS bf16x8*)(QT + (16 * tb + lr) * 136 + 32 * ks + 8 * g);
            f32x4 st[2][2];
#pragma unroll
            for (int sb = 0; sb < 2; ++sb)
#pragma unroll
                for (int tb = 0; tb < 2; ++tb) { f32x4 a = (f32x4){0.f, 0.f, 0.f, 0.f};
#pragma unroll
                    for (int ks = 0; ks < 4; ++ks) a = MFMA16(*(const LAS bf16x8*)(KT + (16 * sb + lr) * 136 + 32 * ks + 8 * g), qf[tb][ks], a);
#pragma unroll
                    for (int j = 0; j < 4; ++j) if (16 * sb + 4 * g + j > 16 * tb + lr) a[j] = 0.f;
                    st[sb][tb] = a; }
            const v2u vlo = *(const LAS v2u*)(VT + (16 * w + lr) * 40 + 4 * g), vhi = *(const LAS v2u*)(VT + (16 * w + lr) * 40 + 16 + 4 * g);
            const bf16x8 vperm = __builtin_bit_cast(bf16x8, (v4u){vlo.x, vlo.y, vhi.x, vhi.y});
#pragma unroll
            for (int tb = 0; tb < 2; ++tb) {
                f32x4 o = (f32x4){0.f, 0.f, 0.f, 0.f};
#pragma unroll
                for (int ks = 0; ks < 4; ++ks) o = MFMA16(*(const LAS bf16x8*)(SLT + (16 * w + lr) * 136 + 32 * ks + 8 * g), qf[tb][ks], o);
                const bf16x8 pf = __builtin_bit_cast(bf16x8, (v4u){pk2(st[0][tb][0], st[0][tb][1]), pk2(st[0][tb][2], st[0][tb][3]), pk2(st[1][tb][0], st[1][tb][1]), pk2(st[1][tb][2], st[1][tb][3])});
                o = MFMA16(vperm, pf, o);
                *(f32x4*)(OLOC + (size_t)(T0 + 32 * ch + 16 * tb + lr) * 1024 + h * 128 + 16 * w + 4 * g) = o;
            }
            const bf16x8 vnat = *(const LAS bf16x8*)(VT + (16 * w + lr) * 40 + 8 * g);
#pragma unroll
            for (int db = 0; db < 8; ++db) {
                Sl[db] = MFMA16(*(const LAS bf16x8*)(KTT + (16 * db + lr) * 40 + 8 * g), vnat, Sl[db]);
                const f32x4 e4 = *(const LAS f32x4*)(EBL + 16 * db + 4 * g); Sl[db] = Sl[db] * e4;
                *(LAS v2u*)(SLT + (16 * w + lr) * 136 + 16 * db + 4 * g) = (v2u){pk2(Sl[db][0], Sl[db][1]), pk2(Sl[db][2], Sl[db][3])};
            }
            if (ch == NCH - 1) {
#pragma unroll
                for (int db = 0; db < 8; ++db) *(f32x4*)(U + ((size_t)(sc * 8 + h) * 16384) + ((w * 8 + db) * 64 + lane) * 4) = Sl[db];
                if (tq == 0) DTOT[(size_t)(sc * 8 + h) * 128 + d] = __expf(Bprev); }
            __syncthreads();
#pragma unroll
            for (int j = 0; j < 8; ++j) { lf[j] = lfn[j]; qr[j] = qrn[j]; vr[j] = vrn[j]; }
            unit = nunit; ch = nch; have = nhave;
        }
    }
#undef HL_LOAD
}
__device__ __forceinline__ void mix_hgrn_sample(const Ctx& c, int l) {
    PHASE_IDS();
    const bf16* P = WSP(bf16, WS_P); const float* LOGF = WSP(float, WS_LOGF); bf16* Y = WSP(bf16, WS_Y);
    LAS float* QF = (LAS float*)(c.lds); LAS float* FF = QF + 512; LAS float* KF = FF + 512; LAS float* VF = KF + 512; LAS float* RED = VF + 512; LAS float* SS = RED + 4 * 16 * 128;
    const int tid = ptid, dg = tid >> 5, d0 = dg * 8, e0 = (tid & 31) * 4;
    f32x4 S[8], Sn[8];
    if (c.bid < DECB * 8) { const float* sp0 = c.state_hgrn + ((size_t)l * DECB * 8 + c.bid) * 16384;
#pragma unroll
        for (int j = 0; j < 8; ++j) S[j] = ldnt((const f32x4*)(sp0 + (size_t)(d0 + j) * 128 + e0)); }
    for (int unit = c.bid; unit < DECB * 8; unit += c.G) {
        const int b = unit >> 3, h = unit & 7; const int r0 = SEQ + 4 * b;
        { const int i = tid >> 7, dd = tid & 127; const size_t rb = (size_t)(r0 + i) * INC + h * 128 + dd;
            QF[tid] = bf2f(P[rb + C_QA]); const float f = __expf(LOGF[(size_t)(r0 + i) * 1024 + h * 128 + dd]); FF[tid] = f; KF[tid] = 1.0f - f; VF[tid] = bf2f(P[rb + C_IA]); }
        __syncthreads();
        if (unit + c.G < DECB * 8) { const float* spn = c.state_hgrn + ((size_t)l * DECB * 8 + unit + c.G) * 16384;
#pragma unroll
            for (int j = 0; j < 8; ++j) Sn[j] = ldnt((const f32x4*)(spn + (size_t)(d0 + j) * 128 + e0)); }
#pragma unroll
        for (int i = 0; i < 4; ++i) { const f32x4 v4 = *(const LAS f32x4*)(VF + i * 128 + e0); f32x4 part = (f32x4){0.f, 0.f, 0.f, 0.f};
#pragma unroll
            for (int j = 0; j < 8; ++j) { const float f = FF[i * 128 + d0 + j], k = KF[i * 128 + d0 + j], q = QF[i * 128 + d0 + j]; S[j] = S[j] * f + v4 * k; part += S[j] * q; }
            *(LAS f32x4*)(RED + (i * 16 + dg) * 128 + e0) = part; }
        float* so = c.out + O_HSS + (((size_t)l * DECB + b) * 8 + h) * 16384;
#pragma unroll
        for (int j = 0; j < 8; ++j) stnt((f32x4*)(so + (size_t)(d0 + j) * 128 + e0), S[j]);
        __syncthreads();
        { const int i = tid >> 7, e = tid & 127; float o = 0.f;
#pragma unroll
            for (int q = 0; q < 16; ++q) o += RED[(i * 16 + q) * 128 + e];
            const float ss = wave_sum(o * o); if (plane == 0) SS[pwave] = ss;
            __syncthreads();
            const float tot = SS[2 * i] + SS[2 * i + 1]; const float rstd = 1.0f / sqrtf(tot * (1.f / 128.f) + EPS);
            const float ga = bf2f(P[(size_t)(r0 + i) * INC + C_GA + h * 128 + e]);
            Y[(size_t)(r0 + i) * 4096 + h * 128 + e] = (bf16)f2bf(o * rstd * c.hgrn_norm_g[l * 1024 + h * 128 + e] * ga); }
        __syncthreads();
#pragma unroll
        for (int j = 0; j < 8; ++j) S[j] = Sn[j];
    }
}

__device__ __forceinline__ void mix_hgrn_scan(const Ctx& c, int l) {
    PHASE_IDS();
    const float* U = WSP(float, WS_U); const float* DTOT = WSP(float, WS_DTOT); bf16* SIN = WSP(bf16, WS_SIN);
    const int gt = c.bid * NT + ptid, NGT = c.G * NT;
    constexpr int UB = (NSC % 16 == 0) ? 16 : (NSC % 4 == 0) ? 4 : (NSC % 2 == 0) ? 2 : 1; static_assert(NSC % UB == 0, "scan batch");
    for (int it = gt; it < 8 * 16384; it += NGT) {
        const int h = it >> 14, idx = it & 16383, j = idx & 3, ln = (idx >> 2) & 63, db = (idx >> 8) & 7, w = idx >> 11, dd = 16 * db + 4 * (ln >> 4) + j, e = 16 * w + (ln & 15);
        float S = 0.f;
        for (int sc0 = 0; sc0 < NSC; sc0 += UB) { float u[UB], dv[UB];
#pragma unroll
            for (int k = 0; k < UB; ++k) { u[k] = ldnt(U + (size_t)((sc0 + k) * 8 + h) * 16384 + idx); dv[k] = DTOT[(size_t)((sc0 + k) * 8 + h) * 128 + dd]; }
#pragma unroll
            for (int k = 0; k < UB; ++k) { SIN[(size_t)((sc0 + k) * 8 + h) * 16384 + idx] = (bf16)f2bf(S); S = S * dv[k] + u[k]; } }
        c.out[O_HSP + ((size_t)l * 8 + h) * 16384 + (size_t)dd * 128 + e] = S;
    }
}
__device__ __forceinline__ void mix_swa_prompt(const Ctx& c, int l) {
    PHASE_IDS();
    const bf16* P = WSP(bf16, WS_P); bf16* Y = WSP(bf16, WS_Y);
    LAS bf16* KI = (LAS bf16*)(c.lds); LAS bf16* VTI = (LAS bf16*)(c.lds + 192 * 72 * 2);
    const int tid = ptid, lane = plane, w = pwave, lr = lane & 15, g = lane >> 4;
    for (int unit = c.bid; unit < 4 * (SEQ / 64); unit += c.G) {
        const int kh = unit & 3, qb = unit >> 2, s0 = 64 * qb - 128;
        for (int it = tid; it < 192 * 8; it += NT) { const int s = it >> 3, ck = it & 7, sa = s0 + s; v4u kv = (v4u){0u, 0u, 0u, 0u}, vv = kv;
            if (sa >= 0) { kv = *(const v4u*)(P + (size_t)sa * INC + C_KC + kh * 64 + ck * 8); vv = *(const v4u*)(P + (size_t)sa * INC + C_VC + kh * 64 + ck * 8); }
            *(LAS v4u*)(KI + s * 72 + ck * 8) = kv;
            LAS bf16* vt = VTI + (ck * 8) * 200 + s;
            vt[0] = (bf16)(vv.x & 0xffff); vt[200] = (bf16)(vv.x >> 16); vt[400] = (bf16)(vv.y & 0xffff); vt[600] = (bf16)(vv.y >> 16);
            vt[800] = (bf16)(vv.z & 0xffff); vt[1000] = (bf16)(vv.z >> 16); vt[1200] = (bf16)(vv.w & 0xffff); vt[1400] = (bf16)(vv.w >> 16); }
        __syncthreads();
        const int hq = 4 * kh + (w >> 1), tq0 = 64 * qb + 32 * (w & 1);
        bf16x8 qf[2][2];
#pragma unroll
        for (int tb = 0; tb < 2; ++tb)
#pragma unroll
            for (int ks = 0; ks < 2; ++ks) qf[tb][ks] = *(const bf16x8*)(P + (size_t)(tq0 + 16 * tb + lr) * INC + C_QC + hq * 64 + 32 * ks + 8 * g);
        const float sink = c.swa_sinks[l * 16 + hq];
        f32x4 st[2][12];
#pragma unroll
        for (int sb = 0; sb < 12; ++sb) {
            const bf16x8 k0 = *(const LAS bf16x8*)(KI + (16 * sb + lr) * 72 + 8 * g), k1 = *(const LAS bf16x8*)(KI + (16 * sb + lr) * 72 + 32 + 8 * g);
#pragma unroll
            for (int tb = 0; tb < 2; ++tb) { f32x4 a = MFMA16(k0, qf[tb][0], ((f32x4){0.f, 0.f, 0.f, 0.f})); a = MFMA16(k1, qf[tb][1], a); st[tb][sb] = a; } }
        float inv[2];
#pragma unroll
        for (int tb = 0; tb < 2; ++tb) {
            const int ta = tq0 + 16 * tb + lr; float mx = sink;
#pragma unroll
            for (int sb = 0; sb < 12; ++sb)
#pragma unroll
                for (int j = 0; j < 4; ++j) { const int sa = s0 + 16 * sb + 4 * g + j; const bool ok = sa >= 0 && sa <= ta && ta - sa < 128; const float v = ok ? st[tb][sb][j] : -1e30f; st[tb][sb][j] = v; mx = fmaxf(mx, v); }
            mx = fmaxf(mx, __shfl_xor(mx, 16)); mx = fmaxf(mx, __shfl_xor(mx, 32));
            float sum = 0.f;
#pragma unroll
            for (int sb = 0; sb < 12; ++sb)
#pragma unroll
                for (int j = 0; j < 4; ++j) { const float p = __expf(st[tb][sb][j] - mx); st[tb][sb][j] = p; sum += p; }
            sum += __shfl_xor(sum, 16); sum += __shfl_xor(sum, 32);
            inv[tb] = 1.0f / (sum + __expf(sink - mx));
        }
        f32x4 o[2][4];
#pragma unroll
        for (int tb = 0; tb < 2; ++tb)
#pragma unroll
            for (int eb = 0; eb < 4; ++eb) o[tb][eb] = (f32x4){0.f, 0.f, 0.f, 0.f};
#pragma unroll
        for (int kk = 0; kk < 6; ++kk) {
            bf16x8 pf[2];
#pragma unroll
            for (int tb = 0; tb < 2; ++tb) pf[tb] = __builtin_bit_cast(bf16x8, (v4u){pk2(st[tb][2 * kk][0], st[tb][2 * kk][1]), pk2(st[tb][2 * kk][2], st[tb][2 * kk][3]), pk2(st[tb][2 * kk + 1][0], st[tb][2 * kk + 1][1]), pk2(st[tb][2 * kk + 1][2], st[tb][2 * kk + 1][3])});
#pragma unroll
            for (int eb = 0; eb < 4; ++eb) { const v2u vlo = *(const LAS v2u*)(VTI + (16 * eb + lr) * 200 + 32 * kk + 4 * g), vhi = *(const LAS v2u*)(VTI + (16 * eb + lr) * 200 + 32 * kk + 16 + 4 * g);
                const bf16x8 vf = __builtin_bit_cast(bf16x8, (v4u){vlo.x, vlo.y, vhi.x, vhi.y});
#pragma unroll
                for (int tb = 0; tb < 2; ++tb) o[tb][eb] = MFMA16(vf, pf[tb], o[tb][eb]); } }
#pragma unroll
        for (int tb = 0; tb < 2; ++tb)
#pragma unroll
            for (int eb = 0; eb < 4; ++eb) { const f32x4 v = o[tb][eb] * inv[tb]; *(v2u*)(Y + (size_t)(tq0 + 16 * tb + lr) * 4096 + 2048 + hq * 64 + 16 * eb + 4 * g) = (v2u){pk2(v[0], v[1]), pk2(v[2], v[3])}; }
        __syncthreads();
    }
}
__device__ __forceinline__ void mix_swa_sample(const Ctx& c, int l) {
    PHASE_IDS();
    const bf16* P = WSP(bf16, WS_P); bf16* Y = WSP(bf16, WS_Y);
    LAS float* KF = (LAS float*)(c.lds); LAS float* VF = KF + 132 * 68; LAS float* SC = VF + 132 * 64; LAS float* DEN = SC + 16 * 136; LAS float* QS = DEN + 16;
    const int tid = ptid;
    for (int unit = c.bid; unit < DECB * 4; unit += c.G) {
        const int b = unit >> 2, kh = unit & 3, r0 = SEQ + 4 * b;
        const float* kc = c.cache_swa_k + ((size_t)l * DECB + b) * 128 * 256 + kh * 64; const float* vc = c.cache_swa_v + ((size_t)l * DECB + b) * 128 * 256 + kh * 64;
        float* ko = c.out + O_KS + ((size_t)l * DECB + b) * 128 * 256 + kh * 64; float* vo = c.out + O_VS + ((size_t)l * DECB + b) * 128 * 256 + kh * 64;
        { f32x4 k4[4], v4[4];
#pragma unroll
            for (int rep = 0; rep < 4; ++rep) { const int it = tid + rep * NT, s = it >> 4, q4 = (it & 15) * 4; k4[rep] = ldnt((const f32x4*)(kc + (size_t)s * 256 + q4)); v4[rep] = ldnt((const f32x4*)(vc + (size_t)s * 256 + q4)); }
#pragma unroll
            for (int rep = 0; rep < 4; ++rep) { const int it = tid + rep * NT, s = it >> 4, q4 = (it & 15) * 4;
                *(LAS f32x4*)(KF + s * 68 + q4) = k4[rep]; *(LAS f32x4*)(VF + s * 64 + q4) = v4[rep];
                if (s >= 4) { stnt((f32x4*)(ko + (size_t)(s - 4) * 256 + q4), k4[rep]); stnt((f32x4*)(vo + (size_t)(s - 4) * 256 + q4), v4[rep]); } } }
        { const float* tab = WSP(float, WS_TAB);
          const int i = tid >> 6, dd = tid & 63;
          if (tid < 256) {
            float kv = bf2f(P[(size_t)(r0 + i) * INC + C_KC + kh * 64 + dd]); const float vv = bf2f(P[(size_t)(r0 + i) * INC + C_VC + kh * 64 + dd]);
            const float ssq = wave_sum(kv * kv); kv = kv * (1.0f / sqrtf(ssq * (1.f / 64.f) + EPS)) * c.swa_knorm_g[l * 64 + dd];
            const float other = __shfl_xor(kv, 8);
            if (dd < 16) { const float cs = tab[T_COSS + i * 8 + (dd & 7)], sn = tab[T_SINS + i * 8 + (dd & 7)]; kv = (dd < 8) ? kv * cs - other * sn : kv * cs + other * sn; }
            KF[(128 + i) * 68 + dd] = kv; VF[(128 + i) * 64 + dd] = vv;
            ko[(size_t)(124 + i) * 256 + dd] = kv; vo[(size_t)(124 + i) * 256 + dd] = vv; } }
        { const float* tab = WSP(float, WS_TAB);
#pragma unroll
          for (int rr = 0; rr < 2; ++rr) { const int qrow = 2 * pwave + rr, qi = qrow >> 2, qh = qrow & 3;
            float qv = bf2f(P[(size_t)(r0 + qi) * INC + C_QC + (4 * kh + qh) * 64 + plane]);
            const float ssq = wave_sum(qv * qv); qv = qv * (0.125f / sqrtf(ssq * (1.f / 64.f) + EPS)) * c.swa_qnorm_g[l * 64 + plane];
            const float other = __shfl_xor(qv, 8);
            if (plane < 16) { const float cs = tab[T_COSS + qi * 8 + (plane & 7)], sn = tab[T_SINS + qi * 8 + (plane & 7)]; qv = (plane < 8) ? qv * cs - other * sn : qv * cs + other * sn; }
            QS[qrow * 64 + plane] = qv; } }
        const int row = tid >> 5, ks = tid & 31, ti = row >> 2, hl = row & 3;
        __syncthreads();
        float q[64];
#pragma unroll
        for (int j = 0; j < 16; ++j) { const f32x4 t4 = *(const LAS f32x4*)(QS + row * 64 + 4 * j); q[4 * j] = t4.x; q[4 * j + 1] = t4.y; q[4 * j + 2] = t4.z; q[4 * j + 3] = t4.w; }
        { const float sink = c.swa_sinks[l * 16 + 4 * kh + hl]; float mx = sink;
            for (int ci = ks; ci < 132; ci += 32) { float s0 = 0.f, s1 = 0.f;
#pragma unroll
                for (int j = 0; j < 16; ++j) { const f32x4 k4 = *(const LAS f32x4*)(KF + ci * 68 + 4 * j); s0 += q[4 * j] * k4.x + q[4 * j + 1] * k4.y; s1 += q[4 * j + 2] * k4.z + q[4 * j + 3] * k4.w; }
                float sv = s0 + s1; const bool ok = ci > ti && ci <= ti + 128; sv = ok ? sv : -1e30f; SC[row * 136 + ci] = sv; mx = fmaxf(mx, sv); }
#pragma unroll
            for (int o = 1; o < 32; o <<= 1) mx = fmaxf(mx, __shfl_xor(mx, o));
            float sum = 0.f;
            for (int ci = ks; ci < 132; ci += 32) { const float p = __expf(SC[row * 136 + ci] - mx); SC[row * 136 + ci] = p; sum += p; }
#pragma unroll
            for (int o = 1; o < 32; o <<= 1) sum += __shfl_xor(sum, o);
            if (ks == 0) DEN[row] = frcp(sum + __expf(sink - mx)); }
        __syncthreads();
        { const int e4 = (tid & 15) * 4, half = (tid >> 4) & 1; f32x4 o = (f32x4){0.f, 0.f, 0.f, 0.f};
#pragma unroll 6
            for (int j = 0; j < 66; ++j) { const int ci = half * 66 + j; o += *(const LAS f32x4*)(VF + ci * 64 + e4) * SC[row * 136 + ci]; }
            o[0] += __shfl_xor(o[0], 16); o[1] += __shfl_xor(o[1], 16); o[2] += __shfl_xor(o[2], 16); o[3] += __shfl_xor(o[3], 16);
            if (half == 0) { const float inv = DEN[row]; *(v2u*)(Y + (size_t)(r0 + ti) * 4096 + 2048 + (4 * kh + hl) * 64 + e4) = (v2u){pk2(o[0] * inv, o[1] * inv), pk2(o[2] * inv, o[3] * inv)}; } }
        __syncthreads();
    }
}
__device__ __forceinline__ void mix_mem_sample(const Ctx& c, int l) {
    PHASE_IDS();
    const bf16* P = WSP(bf16, WS_P); bf16* Y = WSP(bf16, WS_Y);
    LAS float* QF = (LAS float*)(c.lds); LAS float* SC = QF + 1024; LAS float* DEN = SC + 1024; LAS float* PART = DEN + 8;
    const int tid = ptid, lane = plane, w = pwave, g = lane >> 4, l16 = lane & 15;
    for (int unit = c.bid; unit < DECB * 4; unit += c.G) {
        const int b = unit >> 2, hm = unit & 3, r0 = SEQ + 4 * b;
        const float* kb = c.cache_mem_k + ((size_t)l * DECB + b) * 256 * 1024 + hm * 256; const float* vb = c.cache_mem_v + ((size_t)l * DECB + b) * 256 * 1024 + hm * 256;
        f32x4 kk[8][4];
#pragma unroll
        for (int it = 0; it < 8; ++it)
#pragma unroll
            for (int cc = 0; cc < 4; ++cc) kk[it][cc] = ldnt((const f32x4*)(kb + (size_t)(32 * w + 4 * it + g) * 1024 + 4 * l16 + 64 * cc));
        if (w < 4) { const bf16* qp = P + (size_t)(r0 + w) * INC + C_QM + hm * 256 + 4 * lane; const v2u raw = *(const v2u*)qp;
            f32x4 q4v = (f32x4){bflo(raw.x), bfhi(raw.x), bflo(raw.y), bfhi(raw.y)}; const float ssq = wave_sum((q4v.x * q4v.x + q4v.y * q4v.y) + (q4v.z * q4v.z + q4v.w * q4v.w));
            const float rstd = 0.0625f / sqrtf(ssq * (1.f / 256.f) + EPS); const f32x4 g4 = *(const f32x4*)(c.mem_qnorm_g + l * 256 + 4 * lane);
            *(LAS f32x4*)(QF + w * 256 + 4 * lane) = q4v * rstd * g4; }
        __syncthreads();
        f32x4 vpre[16];
#pragma unroll
        for (int it = 0; it < 8; ++it) { const int s = 32 * w + 4 * it + g;
            if (it == 4) {
#pragma unroll
                for (int j = 0; j < 8; ++j) vpre[j] = ldnt((const f32x4*)(vb + (size_t)(32 * w + j) * 1024 + 4 * lane)); }
            float d[4]; int qz = 0; OPQ_S(qz);
#pragma unroll
            for (int i = 0; i < 4; ++i) { f32x4 a = (f32x4){0.f, 0.f, 0.f, 0.f};
#pragma unroll
                for (int cc = 0; cc < 4; ++cc) a += *(const LAS f32x4*)(QF + qz + i * 256 + 64 * cc + 4 * l16) * kk[it][cc];
                d[i] = (a.x + a.y) + (a.z + a.w); }
#pragma unroll
            for (int o = 1; o < 16; o <<= 1) {
#pragma unroll
                for (int i = 0; i < 4; ++i) d[i] += __shfl_xor(d[i], o); }
            if (l16 < 4) SC[l16 * 256 + s] = (l16 == 0) ? d[0] : (l16 == 1) ? d[1] : (l16 == 2) ? d[2] : d[3]; }
#pragma unroll
        for (int j = 8; j < 16; ++j) vpre[j] = ldnt((const f32x4*)(vb + (size_t)(32 * w + j) * 1024 + 4 * lane));
        __syncthreads();
        if (w < 4) { const f32x4 s4 = *(const LAS f32x4*)(SC + w * 256 + 4 * lane); float mx = fmaxf(fmaxf(s4.x, s4.y), fmaxf(s4.z, s4.w));
#pragma unroll
            for (int o = 1; o < 64; o <<= 1) mx = fmaxf(mx, __shfl_xor(mx, o));
            f32x4 p4; p4.x = __expf(s4.x - mx); p4.y = __expf(s4.y - mx); p4.z = __expf(s4.z - mx); p4.w = __expf(s4.w - mx);
            const float sum = wave_sum((p4.x + p4.y) + (p4.z + p4.w)); *(LAS f32x4*)(SC + w * 256 + 4 * lane) = p4; if (lane == 0) DEN[w] = 1.0f / sum; }
        f32x4 vlast[16];
#pragma unroll
        for (int j = 0; j < 16; ++j) vlast[j] = ldnt((const f32x4*)(vb + (size_t)(32 * w + 16 + j) * 1024 + 4 * lane));
        __syncthreads();
        f32x4 acc[4];
#pragma unroll
        for (int i = 0; i < 4; ++i) acc[i] = (f32x4){0.f, 0.f, 0.f, 0.f};
#pragma unroll
        for (int it = 0; it < 16; ++it) { const int s = 32 * w + it;
#pragma unroll
            for (int i = 0; i < 4; ++i) acc[i] += vpre[it] * SC[i * 256 + s]; }
#pragma unroll
        for (int it = 0; it < 16; ++it) { const int s = 32 * w + 16 + it;
#pragma unroll
            for (int i = 0; i < 4; ++i) acc[i] += vlast[it] * SC[i * 256 + s]; }
#pragma unroll
        for (int i = 0; i < 4; ++i) *(LAS f32x4*)(PART + (w * 4 + i) * 256 + 4 * lane) = acc[i];
        __syncthreads();
        for (int it = tid; it < 1024; it += NT) { const int i = it >> 8, e = it & 255; float o = 0.f;
#pragma unroll
            for (int q = 0; q < 8; ++q) o += PART[(q * 4 + i) * 256 + e];
            Y[(size_t)(r0 + i) * 4096 + 3072 + hm * 256 + e] = (bf16)f2bf(o * DEN[i]); }
        __syncthreads();
    }
}

__device__ __forceinline__ void mix_hgrn_final(const Ctx& c, int l) {
    PHASE_IDS();
    const bf16* P = WSP(bf16, WS_P); const float* OLOC = WSP(float, WS_OLOC); const bf16* SIN = WSP(bf16, WS_SIN); bf16* Y = WSP(bf16, WS_Y);
    LAS bf16* SI = (LAS bf16*)(c.lds);
    const int tid = ptid, lane = plane, w = pwave, lr = lane & 15, g = lane >> 4;
    for (int unit = c.bid; unit < 8 * NSC; unit += c.G) {
        const int h = unit & 7, sc = unit >> 3;
        { v4u sv[4];
#pragma unroll
          for (int k = 0; k < 4; ++k) sv[k] = ldnt((const v4u*)(SIN + (size_t)(sc * 8 + h) * 16384 + (tid + k * NT) * 8));
#pragma unroll
          for (int k = 0; k < 4; ++k) *(LAS v4u*)(SI + (tid + k * NT) * 8) = sv[k]; }
        bf16x8 qf[4]; f32x4 o[8];
#pragma unroll 1
        for (int ps = 0; ps < SCT / 128; ++ps) {
            const int t = sc * SCT + 128 * ps + 16 * w + lr;
#pragma unroll
            for (int ks = 0; ks < 4; ++ks) qf[ks] = *(const bf16x8*)(P + (size_t)t * INC + C_QA + h * 128 + 32 * ks + 8 * g);
#pragma unroll
            for (int eb = 0; eb < 8; ++eb) o[eb] = ldnt((const f32x4*)(OLOC + (size_t)t * 1024 + h * 128 + 16 * eb + 4 * g));
            if (ps == 0) __syncthreads();
            float ss = 0.f;
#pragma unroll
            for (int eb = 0; eb < 8; ++eb) { f32x4 a = o[eb];
#pragma unroll
                for (int ks = 0; ks < 4; ++ks) { const int idx = ((eb * 8 + 2 * ks + (g >> 1)) * 64 + (2 * (g & 1)) * 16 + lr) * 4;
                    const v2u lo = *(const LAS v2u*)(SI + idx), hi = *(const LAS v2u*)(SI + idx + 64);
                    a = MFMA16(__builtin_bit_cast(bf16x8, (v4u){lo.x, lo.y, hi.x, hi.y}), qf[ks], a); }
                o[eb] = a; ss += (a[0] * a[0] + a[1] * a[1]) + (a[2] * a[2] + a[3] * a[3]); }
            ss += __shfl_xor(ss, 16); ss += __shfl_xor(ss, 32);
            const float rstd = 1.0f / sqrtf(ss * (1.f / 128.f) + EPS);
#pragma unroll
            for (int eb = 0; eb < 8; ++eb) { const int e = h * 128 + 16 * eb + 4 * g; const f32x4 g4 = *(const f32x4*)(c.hgrn_norm_g + l * 1024 + e); const v2u gw = *(const v2u*)(P + (size_t)t * INC + C_GA + e);
                const f32x4 v = o[eb] * rstd * g4; *(v2u*)(Y + (size_t)t * 4096 + e) = (v2u){pk2(v[0] * bflo(gw.x), v[1] * bfhi(gw.x)), pk2(v[2] * bflo(gw.y), v[3] * bfhi(gw.y))}; }
        }
        __syncthreads();
    }
}

__device__ __forceinline__ void ldf8(const float* p, float (&f)[8]) { const f32x4 a = *(const f32x4*)p, b = *(const f32x4*)(p + 4); f[0] = a.x; f[1] = a.y; f[2] = a.z; f[3] = a.w; f[4] = b.x; f[5] = b.y; f[6] = b.z; f[7] = b.w; }
struct ConvItem { v4u a[6], v[4]; f32x4 s[4]; int r0, c8; bool smp, ok; };
__device__ __forceinline__ void conv_load(ConvItem& I, int it, int nitems, const bf16* AV, const float* state_conv, int l) {
    I.ok = it < nitems; const int it2 = I.ok ? it : 0; const int rg = it2 / (DFF / 8); I.c8 = (it2 % (DFF / 8)) * 8; I.r0 = 4 * rg; I.smp = I.r0 >= SEQ;
#pragma unroll
    for (int i = 0; i < 4; ++i) { I.a[2 + i] = (i < 2) ? ldnt((const v4u*)(AV + (size_t)(I.r0 + i) * 2 * DFF + I.c8)) : *(const v4u*)(AV + (size_t)(I.r0 + i) * 2 * DFF + I.c8); I.v[i] = ldnt((const v4u*)(AV + (size_t)(I.r0 + i) * 2 * DFF + DFF + I.c8)); }
    I.a[0] = (v4u){0u, 0u, 0u, 0u}; I.a[1] = I.a[0];
#pragma unroll
    for (int i = 0; i < 4; ++i) I.s[i] = (f32x4){0.f, 0.f, 0.f, 0.f};
    if (I.smp) { const float* sp = state_conv + ((size_t)l * DECB + (I.r0 - SEQ) / 4) * 2 * DFF + I.c8; I.s[0] = *(const f32x4*)sp; I.s[1] = *(const f32x4*)(sp + 4); I.s[2] = *(const f32x4*)(sp + DFF); I.s[3] = *(const f32x4*)(sp + DFF + 4); }
    else if (I.r0 >= 2) { I.a[0] = *(const v4u*)(AV + (size_t)(I.r0 - 2) * 2 * DFF + I.c8); I.a[1] = *(const v4u*)(AV + (size_t)(I.r0 - 1) * 2 * DFF + I.c8); }
}
__device__ __forceinline__ void conv_compute(const ConvItem& I, const float* cw, const float* cb, bf16* ACT, float* out, int l) {
    if (!I.ok) return;
    float x[6][8], w0[8], w1[8], w2[8], bb[8];
    ldf8(cw + I.c8, w0); ldf8(cw + DFF + I.c8, w1); ldf8(cw + 2 * DFF + I.c8, w2); ldf8(cb + I.c8, bb);
#pragma unroll
    for (int i = 0; i < 6; ++i) unpack8(I.a[i], x[i]);
    if (I.smp) {
#pragma unroll
        for (int j = 0; j < 4; ++j) { x[0][j] = I.s[0][j]; x[0][4 + j] = I.s[1][j]; x[1][j] = I.s[2][j]; x[1][4 + j] = I.s[3][j]; } }
#pragma unroll
    for (int i = 0; i < 4; ++i) { float v[8], o[8]; unpack8(I.v[i], v);
#pragma unroll
        for (int j = 0; j < 8; ++j) o[j] = gelu_as(bb[j] + w0[j] * x[i][j] + w1[j] * x[i + 1][j] + w2[j] * x[i + 2][j]) * v[j];
        *(v4u*)(ACT + (size_t)(I.r0 + i) * DFF + I.c8) = pack8(o); }
    float* dst = nullptr;
    if (I.smp) dst = out + O_CVS + ((size_t)l * DECB + (I.r0 - SEQ) / 4) * 2 * DFF + I.c8; else if (I.r0 == SEQ - 4) dst = out + O_CVP + (size_t)l * 2 * DFF + I.c8;
    if (dst) { *(f32x4*)dst = (f32x4){x[4][0], x[4][1], x[4][2], x[4][3]}; *(f32x4*)(dst + 4) = (f32x4){x[4][4], x[4][5], x[4][6], x[4][7]};
        *(f32x4*)(dst + DFF) = (f32x4){x[5][0], x[5][1], x[5][2], x[5][3]}; *(f32x4*)(dst + DFF + 4) = (f32x4){x[5][4], x[5][5], x[5][6], x[5][7]}; }
}
__device__ __forceinline__ void phase_convact(const Ctx& c, int l) {
    PHASE_IDS();
    const bf16* AV = WSP(bf16, WS_P); bf16* ACT = WSP(bf16, WS_ACT);
    const float* cw = c.conv_w + (size_t)l * 3 * DFF; const float* cb = c.conv_b + (size_t)l * DFF;
    const int gt = c.bid * NT + ptid, NGT = c.G * NT; constexpr int NIT = (M / 4) * (DFF / 8);
    for (int it = gt; it < NIT; it += 2 * NGT) {
        ConvItem A, B; conv_load(A, it, NIT, AV, c.state_conv, l); conv_load(B, it + NGT, NIT, AV, c.state_conv, l);
        conv_compute(A, cw, cb, ACT, c.out, l); conv_compute(B, cw, cb, ACT, c.out, l);
    }
}

__device__ __forceinline__ void phase_merge_sample(const Ctx& c) {
    PHASE_IDS();
    const float* PART = WSP(float, WS_PART); bf16* MG = WSP(bf16, WS_MERGED); const int gw = c.bid * NWAVES + pwave, NGW = c.G * NWAVES;
    for (int r = gw; r < NS; r += NGW) { f32x4 v[8];
#pragma unroll
        for (int j = 0; j < 8; ++j) v[j] = (f32x4){0.f, 0.f, 0.f, 0.f};
        for (int ks = 0; ks < 8; ++ks) { const f32x4* pr = (const f32x4*)(PART + ((size_t)ks * NS + r) * DM) + plane;
#pragma unroll
            for (int j = 0; j < 8; ++j) v[j] += pr[64 * j]; }
        v2u* o = (v2u*)(MG + (size_t)(SEQ + r) * DM) + plane;
#pragma unroll
        for (int j = 0; j < 8; ++j) o[64 * j] = (v2u){pk2(v[j].x, v[j].y), pk2(v[j].z, v[j].w)}; }
}

#ifndef NCV0
#define NCV0 24
#endif
#ifndef NCV1
#define NCV1 8
#endif
#ifndef NSW
#define NSW 32
#endif
#ifndef NA_ITEMS
#define NA_ITEMS 16000
#endif
constexpr int NPH = 1 + 12 * DEPTH;
constexpr int RING_BYTES = 131072, MISC_OFF = RING_BYTES, LDS_BYTES = 147456;
#ifdef EMU
void fwd_kernel(void* vp) { const Args& args = *(const Args*)vp; unsigned char* lds = emu_lds;
#else
__global__ void __launch_bounds__(NT, 2) fwd_kernel(Args args) {
    extern __shared__ __attribute__((aligned(16))) unsigned char lds[];
#endif
#ifdef EMU
    const int wave0 = threadIdx.x >> 6;
#define LOADCTX() Ctx c = make_ctx(args, lds, wave0)
#else
    const __attribute__((address_space(4))) char* kp0 = (const __attribute__((address_space(4))) char*)__builtin_amdgcn_kernarg_segment_ptr();
    const int wave0 = __builtin_amdgcn_readfirstlane(threadIdx.x >> 6);
#define LOADCTX() Ctx c = make_ctx(kp0, (LAS unsigned char*)lds, wave0)
#endif
    const int lo = args.ph_lo, hi = args.ph_hi;
#ifndef EMU
    volatile LAS unsigned* misc = (volatile LAS unsigned*)((LAS unsigned char*)lds + MISC_OFF);
    if (threadIdx.x < 16) misc[threadIdx.x] = 0u;
    __syncthreads();
    XcdBarrier bar; bar.bar = (unsigned*)(args.ws + WS_CTL) + 1024; bar.x = 0; bar.st = nullptr; bar.w0 = wave0;
    if (hi - lo > 1) { bar = xcd_barrier_post((unsigned*)(args.ws + WS_CTL) + 1024, misc + 8); bar.w0 = wave0; }
#define SEAM(k) do { if (IN(k) && IN((k) + 1)) xcd_barrier(bar); } while (0)
#else
#define SEAM(k) do { } while (0)
#endif
#define IN(k) in_phase(lo, hi, (k))
#ifndef PH_MASK
#define PH_MASK 0xfff
#endif
#define EN(kind) (((PH_MASK) >> (kind)) & 1)
#ifndef SUB_MASK
#define SUB_MASK 0xffff
#endif
#define SUB(k) (((SUB_MASK) >> (k)) & 1)
    if (EN(0) && IN(0)) { LOADCTX(); phase_prologue(c); }
    SEAM(0);
#pragma unroll 1
    for (int l = 0; l < DEPTH; ++l) {
        const int pb = 12;
        if (l > 0) { if (EN(7) && IN(pb)) { LOADCTX(); phase_rmsnorm(c, c.norm1_g + (size_t)l * DM, c.out + O_Y + (size_t)SEQ * DM, 11, true); } SEAM(pb); }
        const int pA = (l == 0) ? 1 : 13, p0 = pA + 1;
        if (EN(1) && IN(pA)) { LOADCTX();
            const int nu = (NPAN - NPP) * (INC / 256), UW = (nu + 8 <= c.G) ? nu : c.G / 2;
            if (c.bid < UW) {
                pg8::Gemm g{WSP(bf16, WS_XN), l == 0 ? WSP(bf16, WS_WIN) : WSP(bf16, WS_WIN1), DM, DM, DM, c.wave0};
                pg8::EpiIn E{WSP(bf16, WS_P), WSP(float, WS_LOGF), WSP(float, WS_TAB) + T_LB + l * 1024, WSP(float, WS_KVRAW), WSP(v4u, WS_GF)};
                pg8::SchedInS S{NPP, NPAN - NPP, INC / 256, UW, c.bid, 0, DM / 64};
                pg8::gemm_phase<pg8::EpiIn, pg8::SchedInS>(c.lds, g, S, E);
            } else { int tv = c.wave0 * 64 + hw_lane(); OPQ_V(tv); const int wv = __builtin_amdgcn_readfirstlane(tv >> 6);
                tr_stream(c, (LAS float*)(c.lds + wv * 16384), (c.bid - UW) * NWAVES + wv, (c.G - UW) * NWAVES, 1 + l, tv & 63, 0, NA_ITEMS); }
        }
        SEAM(pA);
        if (EN(1) && IN(p0)) { LOADCTX();
            const int NCV = c.G >= 64 ? (l == 0 ? NCV0 : NCV1) : 1;
            if (c.bid < NCV) { int tv = c.wave0 * 64 + hw_lane(); OPQ_V(tv); const int wv = __builtin_amdgcn_readfirstlane(tv >> 6);
                tr_stream(c, (LAS float*)(c.lds + wv * 16384), c.bid * NWAVES + wv, NCV * NWAVES, 1 + l, tv & 63, NA_ITEMS); }
        }
        if (EN(2) && IN(p0)) { LOADCTX();
            const int NCV = c.G >= 64 ? (l == 0 ? NCV0 : NCV1) : 1, SW0 = c.G >= 64 ? NCV : 0, nsw = c.G >= 64 ? NSW : 1;
            if (c.bid >= SW0 && c.bid < SW0 + nsw) { Ctx cs = c; cs.bid = c.bid - SW0; cs.G = nsw;
                mix_mem_sample(cs, l); }
        }
        if (EN(1) && IN(p0)) { LOADCTX();
            pg8::Gemm g{WSP(bf16, WS_XN), l == 0 ? WSP(bf16, WS_WIN) : WSP(bf16, WS_WIN1), DM, DM, DM, c.wave0};
            pg8::EpiIn E{WSP(bf16, WS_P), WSP(float, WS_LOGF), WSP(float, WS_TAB) + T_LB + l * 1024, WSP(float, WS_KVRAW), WSP(v4u, WS_GF)};
            {
                const int NR = c.G >= 64 ? (l == 0 ? NCV0 : NCV1) + NSW : 1, GP = c.G - NR, nextra = l == 0 ? 16 : 0, total = NPP * (INC / 256) + nextra;
                int rs = total / GP; if (rs > 9) rs = 9; const int nstatic = rs * GP;
                unsigned* pool = (unsigned*)(c.ws + WS_CTL) + 8192 + 64 * l; volatile LAS unsigned* slot = (volatile LAS unsigned*)(c.lds + MISC_OFF) + 4;
                pg8::SchedIn S{NPP, INC / 256, GP, c.bid < NR ? 0 : c.bid - NR, nextra, DM / 64, c.bid < NR ? 0 : nstatic};
#pragma unroll 1
                for (;;) {
                    pg8::gemm_phase<pg8::EpiIn, pg8::SchedIn>(c.lds, g, S, E);
                    if (nstatic >= total) break;
                    __syncthreads();
                    if (c.wave0 == 0 && hw_lane() == 0) *slot = atomicAdd(pool, 1u);
                    __syncthreads();
                    const int k = nstatic + (int)*slot; if (k >= total) break;
                    S.G = 1 << 28; S.c = k; S.limit = k + 1;
                }
            }
        }
        SEAM(p0);
        if (EN(2) && IN(p0 + 1)) { LOADCTX();
            const bool alt = ((c.bid >> 3) & 1) != 0;
#pragma unroll 1
            for (int step = 0; step < 2; ++step) {
                if ((step == 0) == alt) { mix_hgrn_local(c, l); }
                else { mix_prep(c, l); if (l == 0) mix_memkv(c); mix_pool(c, l, true, true); mix_hgrn_sample(c, l); }
                __syncthreads();
            }
        }
        SEAM(p0 + 1);
        if (EN(3) && IN(p0 + 2)) { LOADCTX();
            const bool alt = ((c.bid >> 3) & 1) != 0;
#pragma unroll 1
            for (int step = 0; step < 2; ++step) {
                if ((step == 0) == alt) { mix_hgrn_scan(c, l); __syncthreads(); mix_swa_sample(c, l); }
                else {
                    { pg8::Gemm g{WSP(bf16, WS_P) + C_QM, WSP(bf16, WS_KMEM) + (size_t)l * 1024 * 256, INC, 256, 256, c.wave0};
                      pg8::SchedGrid S{NPP, 4, c.G, c.bid, 256, 4}; pg8::EpiMemS E{WSP(bf16, WS_E), WSP(float, WS_ROWSUM) + (size_t)l * SEQ * 4};
                      pg8::gemm_phase<pg8::EpiMemS, pg8::SchedGrid>(c.lds, g, S, E); }
                    __syncthreads();
                    { pg8::Gemm g{WSP(bf16, WS_D), WSP(bf16, WS_WPL) + (size_t)l * 1024 * 256, 1024, 256, 256, c.wave0};
                      pg8::SchedGrid S{NPAN, 4, c.G, (c.bid + c.G / 2) % c.G, 256, 4}; pg8::EpiBf16S E{WSP(bf16, WS_Y), 4096, 1024, 256, c.pool_scale + (size_t)l * 1024, nullptr, 0};
                      pg8::gemm_phase<pg8::EpiBf16S, pg8::SchedGrid>(c.lds, g, S, E); }
                    __syncthreads();
                    mix_swa_prompt(c, l);
                }
                __syncthreads();
            }
        }
        SEAM(p0 + 2);
        if (EN(4) && IN(p0 + 3)) { LOADCTX();
            if (SUB(5)) { pg8::Gemm g{WSP(bf16, WS_E), WSP(bf16, WS_VMEMT) + (size_t)l * 1024 * 256, 1024, 256, 256, c.wave0};
              pg8::SchedGrid S{NPP, 4, c.G, c.bid, 256, 4}; pg8::EpiBf16S E{WSP(bf16, WS_Y), 4096, 3072, 256, nullptr, WSP(float, WS_ROWSUM) + (size_t)l * SEQ * 4, 4};
              pg8::gemm_phase<pg8::EpiBf16S, pg8::SchedGrid>(c.lds, g, S, E); }
            __syncthreads();
            if (SUB(6)) { pg8::Gemm g{WSP(bf16, WS_Y), WSP(bf16, WS_WBR) + (size_t)l * 8192 * 1024, 4096, 1024, 1024, c.wave0};
              pg8::SchedBranchS S{NPP, NPAN - NPP, c.G, (c.bid + c.G / 2) % c.G}; pg8::EpiBranch E{WSP(bf16, WS_P), WSP(v4u, WS_GF), WSP(v4u, WS_MACC) + (size_t)c.bid * 8192, WSP(bf16, WS_MERGED), WSP(float, WS_PART)};
              pg8::gemm_phase<pg8::EpiBranch, pg8::SchedBranchS>(c.lds, g, S, E); }
            __syncthreads();
            if (SUB(7)) mix_hgrn_final(c, l);
        }
        SEAM(p0 + 3);
        if (EN(5) && IN(p0 + 4)) { LOADCTX();
            pg8::Gemm g{WSP(bf16, WS_Y), WSP(bf16, WS_WBR) + (size_t)l * 8192 * 1024, 4096, 1024, 1024, c.wave0};
            phase_merge_sample(c);
            pg8::SchedBranch S{NPP, c.G, c.bid}; pg8::EpiBranch E{WSP(bf16, WS_P), WSP(v4u, WS_GF), WSP(v4u, WS_MACC) + (size_t)c.bid * 8192, WSP(bf16, WS_MERGED), WSP(float, WS_PART)};
            pg8::gemm_phase<pg8::EpiBranch, pg8::SchedBranch>(c.lds, g, S, E);
        }
        SEAM(p0 + 4);
        if (EN(6) && IN(p0 + 5)) { LOADCTX();
            pg8::Gemm g{WSP(bf16, WS_MERGED), WSP(bf16, WS_WO) + (size_t)l * DM * DM, DM, DM, DM, c.wave0};
            pg8::SchedSplit S{NPP, NPAN - NPP, c.G, c.bid, 8, DM / 64};
            pg8::EpiRes E{l == 0 ? c.x_prompt : c.out + O_Y, l == 0 ? c.x_sample : c.out + O_Y + (size_t)SEQ * DM, c.out + O_Y, WSP(float, WS_PART)};
            pg8::gemm_phase<pg8::EpiRes, pg8::SchedSplit>(c.lds, g, S, E);
        }
        SEAM(p0 + 5);
        if (EN(7) && IN(p0 + 6)) { LOADCTX(); phase_rmsnorm(c, c.norm2_g + (size_t)l * DM, l == 0 ? c.x_sample : c.out + O_Y + (size_t)SEQ * DM, 8, true); }
        SEAM(p0 + 6);
        if (EN(8) && IN(p0 + 7)) { LOADCTX();
            pg8::Gemm g{WSP(bf16, WS_XN), WSP(bf16, WS_WUP) + (size_t)l * 2 * DFF * DM, DM, DM, DM, c.wave0};
            pg8::SchedGrid S{NPAN, 2 * DFF / 256, c.G, c.bid, 0, DM / 64}; pg8::EpiBf16S E{WSP(bf16, WS_P), 2 * DFF, 0, 256, nullptr, nullptr, 0};
            pg8::gemm_phase<pg8::EpiBf16S, pg8::SchedGrid>(c.lds, g, S, E);
        }
        SEAM(p0 + 7);
        if (EN(9) && IN(p0 + 8)) { LOADCTX(); phase_convact(c, l); }
        SEAM(p0 + 8);
        if (EN(10) && IN(p0 + 9)) { LOADCTX();
            pg8::Gemm g{WSP(bf16, WS_ACT), WSP(bf16, WS_WDN) + (size_t)l * DM * DFF, DFF, DFF, DFF, c.wave0};
            pg8::SchedSplit S{NPP, NPAN - NPP, c.G, c.bid, 11, DFF / 64}; pg8::EpiRes E{c.out + O_Y, c.out + O_Y + (size_t)SEQ * DM, c.out + O_Y, WSP(float, WS_PART)};
            pg8::gemm_phase<pg8::EpiRes, pg8::SchedSplit>(c.lds, g, S, E);
        }
        SEAM(p0 + 9);
    }
    if (EN(7) && IN(NPH - 1)) { LOADCTX(); phase_rmsnorm(c, nullptr, c.out + O_Y + (size_t)SEQ * DM, 11, false); }
#undef IN
#undef SEAM
}

extern "C" void kernel_launch(void* const* d_in, const int* in_sizes, int n_in, void* d_out, int out_size, void* d_ws, size_t ws_size, hipStream_t stream) {
    if (n_in != 30 || (size_t)out_size != O_END || ws_size < WS_END) { fprintf(stderr, "kernel_launch: shape mismatch: n_in %d out %d (want %zu) ws %zu (want %zu)\n", n_in, out_size, (size_t)O_END, ws_size, (size_t)WS_END); return; }
    Args a{};
    for (int i = 0; i < 30; ++i) a.in[i] = (const float*)d_in[i];
    a.out = (float*)d_out; a.ws = (unsigned char*)d_ws;
    (void)hipMemsetAsync((char*)d_ws + WS_CTL, 0, ZERO_BYTES, stream);
#ifdef EMU
    const char* pe = getenv("EMU_PH_LO"); const char* ph = getenv("EMU_PH_HI"); const int plo = pe ? atoi(pe) : 0, phi = ph ? atoi(ph) : NPH;
    for (int p = plo; p < phi; ++p) { a.ph_lo = p; a.ph_hi = p + 1; fprintf(stderr, "[emu] phase %d\n", p); emu_launch(fwd_kernel, &a, getenv("EMU_G") ? atoi(getenv("EMU_G")) : 2, NT, LDS_BYTES); }
#else
    static int grid = 0;
    if (grid == 0) {
        int dev = 0, cus = 0;
        if (hipGetDevice(&dev) != hipSuccess || hipDeviceGetAttribute(&cus, hipDeviceAttributeMultiprocessorCount, dev) != hipSuccess) { grid = -1; return; }
        if (hipFuncSetAttribute((const void*)fwd_kernel, hipFuncAttributeMaxDynamicSharedMemorySize, LDS_BYTES) != hipSuccess) { fprintf(stderr, "kernel_launch: hipFuncSetAttribute failed\n"); grid = -1; return; }
        int per_cu = 0; (void)hipOccupancyMaxActiveBlocksPerMultiprocessor(&per_cu, (const void*)fwd_kernel, NT, LDS_BYTES); (void)hipGetLastError();
        grid = cus;
    }
    if (grid < 0) return;
    if (MK_N_LAUNCHES == 1) { a.ph_lo = 0; a.ph_hi = NPH; hipLaunchKernelGGL(fwd_kernel, dim3(grid), dim3(NT), LDS_BYTES, stream, a); }
    else for (int p = 0; p < NPH; ++p) { a.ph_lo = p; a.ph_hi = p + 1; hipLaunchKernelGGL(fwd_kernel, dim3(grid), dim3(NT), LDS_BYTES, stream, a); }
#endif
}
#ifdef EMU
size_t emu_ws_bytes() { return WS_END; }
size_t emu_out_floats() { return O_END; }
#include "emu_wsmap.h"
#endif
```
